# Optimizing an MI355X kernel written in HIP

```python
import math
import jax, jax.numpy as jnp
from jax import lax
import numpy as np

D_MODEL = 2048
BATCH = 4
SEQ = 4096
DEPTH = 4

HEAD_DIM = 128
N_FOX_HEADS = 8
N_SB_HEADS = 8
FOX_W = N_FOX_HEADS * HEAD_DIM
SB_W = N_SB_HEADS * HEAD_DIM
MIX_W = FOX_W + SB_W
ATT_IN_COLS = 3 * FOX_W + N_FOX_HEADS + 3 * SB_W
ATT_SPLITS = [FOX_W, 2 * FOX_W, 3 * FOX_W, 3 * FOX_W + N_FOX_HEADS,
              3 * FOX_W + N_FOX_HEADS + SB_W, 3 * FOX_W + N_FOX_HEADS + 2 * SB_W]
Q_BLOCK = 128
CONV_WIDTH = 3
D_FF = 5632
N_EXPERTS = 8
TOP_K = 2
D_FF_EXPERT = 2816
N_EVEN = (DEPTH + 1) // 2
N_ODD = DEPTH // 2
RMS_EPS = 1e-6

kernel_name = "fox_stickbreak_shortconv_moe_hybrid"


def rmsnorm(x, g):
    xf = x.astype(jnp.float32)
    inv = lax.rsqrt(jnp.mean(xf * xf, axis=-1, keepdims=True) + RMS_EPS)
    return (xf * inv).astype(x.dtype) * g


def split_heads(t, n_heads):
    b, s, _ = t.shape
    return t.reshape(b, s, n_heads, HEAD_DIM).transpose(0, 2, 1, 3)


def merge_blocks(out):
    nb, b, h, qb, dh = out.shape
    return out.transpose(1, 2, 0, 3, 4).reshape(b, h, nb * qb, dh)


def fox_attention(q, k, v, log_f):
    seq = q.shape[2]
    scale = 1.0 / math.sqrt(HEAD_DIM)
    c = jnp.cumsum(log_f, axis=-1)
    key_pos = jnp.arange(seq)

    def one_block(i):
        start = i * Q_BLOCK
        qb = lax.dynamic_slice_in_dim(q, start, Q_BLOCK, axis=2)
        cb = lax.dynamic_slice_in_dim(c, start, Q_BLOCK, axis=2)
        q_pos = start + jnp.arange(Q_BLOCK)
        s = jnp.einsum('bhqd,bhkd->bhqk', qb, k).astype(jnp.float32) * scale
        s = s + cb[..., :, None] - c[..., None, :]
        causal = key_pos[None, :] <= q_pos[:, None]
        s = jnp.where(causal, s, -jnp.inf)
        p = jax.nn.softmax(s, axis=-1)
        return jnp.einsum('bhqk,bhkd->bhqd', p.astype(v.dtype), v)

    return merge_blocks(lax.map(one_block, jnp.arange(seq // Q_BLOCK)))


def stick_breaking_attention(q, k, v):
    seq = q.shape[2]
    scale = 1.0 / math.sqrt(HEAD_DIM)
    key_pos = jnp.arange(seq)

    def one_block(i):
        start = i * Q_BLOCK
        qb = lax.dynamic_slice_in_dim(q, start, Q_BLOCK, axis=2)
        q_pos = start + jnp.arange(Q_BLOCK)
        z = jnp.einsum('bhqd,bhkd->bhqk', qb, k).astype(jnp.float32) * scale
        strict = key_pos[None, :] < q_pos[:, None]
        log_beta = jax.nn.log_sigmoid(z)
        log_one_minus = jnp.where(strict, jax.nn.log_sigmoid(-z), 0.0)
        rev_incl = lax.cumsum(log_one_minus, axis=3, reverse=True)
        rev_excl = jnp.concatenate([rev_incl[..., 1:], jnp.zeros_like(rev_incl[..., :1])], axis=-1)
        log_a = jnp.where(strict, log_beta + rev_excl, -jnp.inf)
        a = jnp.exp(log_a)
        return jnp.einsum('bhqk,bhkd->bhqd', a.astype(v.dtype), v)

    return merge_blocks(lax.map(one_block, jnp.arange(seq // Q_BLOCK)))


def attention_mixer(h, w_in, b_forget, w_out):
    b, s, _ = h.shape
    proj = h @ w_in
    qa, ka, va, fa, qb, kb, vb = jnp.split(proj, ATT_SPLITS, axis=-1)
    log_f = jax.nn.log_sigmoid((fa + b_forget).astype(jnp.float32)).transpose(0, 2, 1)
    oa = fox_attention(split_heads(qa, N_FOX_HEADS), split_heads(ka, N_FOX_HEADS),
                       split_heads(va, N_FOX_HEADS), log_f)
    ob = stick_breaking_attention(split_heads(qb, N_SB_HEADS), split_heads(kb, N_SB_HEADS),
                                  split_heads(vb, N_SB_HEADS))
    o = jnp.concatenate([oa, ob], axis=1)
    o = o.transpose(0, 2, 1, 3).reshape(b, s, MIX_W)
    return o @ w_out


def short_conv_mixer(h, w_in, conv_w, w_out):
    seq = h.shape[1]
    gate_b, gate_c, u = jnp.split(h @ w_in, 3, axis=-1)
    g = gate_c * u
    gp = jnp.pad(g, ((0, 0), (CONV_WIDTH - 1, 0), (0, 0)))
    conv = sum(gp[:, j:j + seq, :] * conv_w[j] for j in range(CONV_WIDTH))
    return (gate_b * conv) @ w_out


def swiglu(h, w_gate, w_up, w_down):
    return (jax.nn.silu(h @ w_gate) * (h @ w_up)) @ w_down


def moe_swiglu(h, w_router, w_gate, w_up, w_down):
    b, s, d = h.shape
    ht = h.reshape(b * s, d)
    logits = (ht @ w_router).astype(jnp.float32)
    top_vals, top_idx = lax.top_k(logits, TOP_K)
    gates = jax.nn.softmax(top_vals, axis=-1)
    combine = jnp.sum(jax.nn.one_hot(top_idx, N_EXPERTS, dtype=jnp.float32) * gates[..., None], axis=1)
    combine = combine.astype(h.dtype)
    out = jnp.zeros_like(ht)
    for e in range(N_EXPERTS):
        out = out + combine[:, e:e + 1] * swiglu(ht, w_gate[e], w_up[e], w_down[e])
    return out.reshape(b, s, d)


def setup_inputs(seed: int = 0) -> dict:
    key = jax.random.key(seed)
    ks = jax.random.split(key, 20)
    D = D_MODEL
    nrm = lambda k, shape, fan_in: jax.random.normal(k, shape, jnp.float32) * (fan_in ** -0.5)
    return {
        "x": jax.random.normal(ks[0], (BATCH, SEQ, D), jnp.float32),
        "mix_norm": 1.0 + 0.02 * jax.random.normal(ks[1], (DEPTH, D), jnp.float32),
        "ffn_norm": 1.0 + 0.02 * jax.random.normal(ks[2], (DEPTH, D), jnp.float32),
        "final_norm": 1.0 + 0.02 * jax.random.normal(ks[3], (D,), jnp.float32),
        "w_in_att": nrm(ks[4], (N_EVEN, D, ATT_IN_COLS), D),
        "b_forget": jax.random.uniform(ks[5], (N_EVEN, N_FOX_HEADS), jnp.float32, 1.0, 4.0),
        "w_out_att": nrm(ks[6], (N_EVEN, MIX_W, D), MIX_W),
        "w_in_conv": nrm(ks[7], (N_ODD, D, 3 * D), D),
        "conv_w": nrm(ks[8], (N_ODD, CONV_WIDTH, D), CONV_WIDTH),
        "w_out_conv": nrm(ks[9], (N_ODD, D, D), D),
        "w_gate_dense": nrm(ks[10], (N_EVEN, D, D_FF), D),
        "w_up_dense": nrm(ks[11], (N_EVEN, D, D_FF), D),
        "w_down_dense": nrm(ks[12], (N_EVEN, D_FF, D), D_FF),
        "w_router": nrm(ks[13], (N_ODD, D, N_EXPERTS), D),
        "w_gate_moe": nrm(ks[14], (N_ODD, N_EXPERTS, D, D_FF_EXPERT), D),
        "w_up_moe": nrm(ks[15], (N_ODD, N_EXPERTS, D, D_FF_EXPERT), D),
        "w_down_moe": nrm(ks[16], (N_ODD, N_EXPERTS, D_FF_EXPERT, D), D_FF_EXPERT),
    }


def reference(x, mix_norm, ffn_norm, final_norm, w_in_att, b_forget, w_out_att,
              w_in_conv, conv_w, w_out_conv, w_gate_dense, w_up_dense, w_down_dense,
              w_router, w_gate_moe, w_up_moe, w_down_moe):
    for i in range(DEPTH):
        j = i // 2
        h = rmsnorm(x, mix_norm[i])
        if i % 2 == 0:
            x = x + attention_mixer(h, w_in_att[j], b_forget[j], w_out_att[j])
        else:
            x = x + short_conv_mixer(h, w_in_conv[j], conv_w[j], w_out_conv[j])
        h = rmsnorm(x, ffn_norm[i])
        if i % 2 == 0:
            x = x + swiglu(h, w_gate_dense[j], w_up_dense[j], w_down_dense[j])
        else:
            x = x + moe_swiglu(h, w_router[j], w_gate_moe[j], w_up_moe[j], w_down_moe[j])
    return rmsnorm(x, final_norm)
```

```cpp
#include <hip/hip_runtime.h>
#include <cstdio>
#include <cstdint>
#define MK_ONE_LAUNCH 1
namespace pg8 {
#define PG8_LAS __attribute__((address_space(3)))
typedef unsigned short bf16_t;
typedef short bf16x8 __attribute__((ext_vector_type(8)));
typedef float f32x4 __attribute__((ext_vector_type(4)));
typedef unsigned u32x4 __attribute__((ext_vector_type(4)));
constexpr int BM = 256, BK = 64, HALF = 128, HTB = HALF * BK * 2  , STAGE_BYTES = 8 * HTB, NXCD = 8, WGM = 8;

__host__ __device__ __forceinline__ int lds_byte(int r, int c) { const int st = (r >> 4) * 2 + (c >> 5), rr = r & 15, cc = c & 31, ob = rr * 64 + cc * 2; return st * 1024 + (ob ^ (((ob >> 9) & 1) << 5)); }
__host__ __device__ __forceinline__ void stage_rc(int b, int& R, int& C) { const int st = b / 1024, sb = b % 1024, swz = sb ^ (((sb >> 9) & 1) << 5); R = (st >> 1) * 16 + swz / 64; C = (st & 1) * 32 + (swz % 64) / 2; }
__host__ __device__ __forceinline__ int perm32(int rho) { const int n = rho >> 4, i = rho & 15; return 8 * (i >> 2) + 4 * n + (i & 3); }

struct Unit { int pm, pn; };
struct Gemm { const bf16_t* A; const bf16_t* Bt; int M, N, K; };

struct StaticOrder {
    int nM, nN, nwg, G, c;
    __host__ __device__ void init(int M, int N, int G_, int c_) { nM = M / BM; nN = N / BM; nwg = nM * nN; G = G_; c = c_; }
    __host__ __device__ bool next(int i, Unit& u) const {
        const long L = (long)i * G + c; if (L >= nwg) return false;
        int wgid = (int)L; { const int q = nwg / NXCD, r = nwg % NXCD, xcd = wgid % NXCD, off = wgid / NXCD; wgid = (xcd < r ? xcd * (q + 1) : r * (q + 1) + (xcd - r) * q) + off; }
        const int nig = WGM * nN, gid = wgid / nig, fm = gid * WGM, gsz = (nM - fm) < WGM ? (nM - fm) : WGM;
        u.pm = fm + ((wgid % nig) % gsz); u.pn = (wgid % nig) / gsz; return true;
    }
    __device__ __forceinline__ void a_ready(const Unit&) const {}
    __device__ __forceinline__ void done(const Unit&) const {}
};

__device__ __forceinline__ unsigned cvt_pk_bf16(float lo, float hi) { unsigned r; asm volatile("v_cvt_pk_bf16_f32 %0, %1, %2" : "=v"(r) : "v"(lo), "v"(hi)); return r; }
typedef float f32x2 __attribute__((ext_vector_type(2)));
typedef unsigned u32x2 __attribute__((ext_vector_type(2)));
struct EpiPlainBf16 {
    static constexpr bool PERM = true, AFTER_DRAIN = false;
    bf16_t* O; int ldc;
    __device__ __forceinline__ void operator()(const f32x4 (&acc)[2][2][4][2], const Unit& u, int wr, int wc, int fr, int fq) const {
        const int row0 = u.pm * BM + wr * 64 + fr, col0 = u.pn * BM + wc * 32 + 8 * fq;
#pragma unroll
        for (int ai = 0; ai < 2; ++ai)
#pragma unroll
            for (int m = 0; m < 4; ++m) { bf16_t* rowp = O + (size_t)(row0 + ai * HALF + m * 16) * ldc + col0;
#pragma unroll
                for (int bj = 0; bj < 2; ++bj) { const f32x4 v0 = acc[ai][bj][m][0], v1 = acc[ai][bj][m][1];
                    u32x4 w; w.x = cvt_pk_bf16(v0[0], v0[1]); w.y = cvt_pk_bf16(v0[2], v0[3]); w.z = cvt_pk_bf16(v1[0], v1[1]); w.w = cvt_pk_bf16(v1[2], v1[3]);
                    *(u32x4*)(rowp + bj * HALF) = w; } }
    }
};
__device__ __forceinline__ float silu_mul(float g, float u) { return g * __builtin_amdgcn_rcpf(1.0f + __builtin_amdgcn_exp2f(-1.4426950408889634f * g)) * u; }
struct EpiSwiGLU {
    static constexpr bool PERM = true, AFTER_DRAIN = false;
    bf16_t* O; int ldc;
    __device__ __forceinline__ void operator()(const f32x4 (&acc)[2][2][4][2], const Unit& u, int wr, int wc, int fr, int fq) const {
        const int row0 = u.pm * BM + wr * 64 + fr, col0 = u.pn * HALF + wc * 32 + 8 * fq;
#pragma unroll
        for (int ai = 0; ai < 2; ++ai)
#pragma unroll
            for (int m = 0; m < 4; ++m) { bf16_t* rowp = O + (size_t)(row0 + ai * HALF + m * 16) * ldc + col0;
                const f32x4 g0 = acc[ai][0][m][0], g1 = acc[ai][0][m][1], u0 = acc[ai][1][m][0], u1 = acc[ai][1][m][1];
                u32x4 w; w.x = cvt_pk_bf16(silu_mul(g0[0], u0[0]), silu_mul(g0[1], u0[1])); w.y = cvt_pk_bf16(silu_mul(g0[2], u0[2]), silu_mul(g0[3], u0[3]));
                w.z = cvt_pk_bf16(silu_mul(g1[0], u1[0]), silu_mul(g1[1], u1[1])); w.w = cvt_pk_bf16(silu_mul(g1[2], u1[2]), silu_mul(g1[3], u1[3]));
                *(u32x4*)rowp = w; }
    }
};
struct EpiRes {
    static constexpr bool PERM = false, AFTER_DRAIN = false;
    const float* base; float* out; int ldc; const float* rs; int rs_stride;
    __device__ __forceinline__ void operator()(const f32x4 (&acc)[2][2][4][2], const Unit& u, int wr, int wc, int fr, int fq) const {
        const int row0 = u.pm * BM + wr * 64 + fr, col0 = u.pn * BM + wc * 32 + 4 * fq;
#pragma unroll
        for (int ai = 0; ai < 2; ++ai)
#pragma unroll
            for (int m = 0; m < 4; ++m) { const int row = row0 + ai * HALF + m * 16; const size_t off = (size_t)row * ldc + col0;
                const float s = rs ? rs[(size_t)row * rs_stride] : 1.0f;
#pragma unroll
                for (int bj = 0; bj < 2; ++bj)
#pragma unroll
                    for (int n = 0; n < 2; ++n) { const f32x4 b = *(const f32x4*)(base + off + bj * HALF + n * 16); *(f32x4*)(out + off + bj * HALF + n * 16) = b + acc[ai][bj][m][n] * s; } }
    }
};
template <class Epi, class Sched, bool ALIGN_EPI = false, bool SP2 = false>
__device__ __forceinline__ void gemm_phase(PG8_LAS unsigned char* lds, const Gemm g, const Sched& S, const Epi& E) {
    int tid_ = threadIdx.x; asm volatile("" : "+v"(tid_));
    const int tid = tid_, wid = __builtin_amdgcn_readfirstlane(tid >> 6), lane = tid & 63, wr = wid >> 2, wc = wid & 3, fr = lane & 15, fq = lane >> 4;
    const int K = g.K, nt = K / BK;
    unsigned voffA[2], voffB[2];
#pragma unroll
    for (int i = 0; i < 2; ++i) { int R, C; stage_rc(tid * 16 + i * 8192, R, C); const int Rb = Epi::PERM ? ((R & ~31) + perm32(R & 31)) : R;
        voffA[i] = (unsigned)(R * K + C) * 2u; voffB[i] = (unsigned)(Rb * K + C) * 2u; }
    const size_t kstep = (size_t)(BK * 2);
    const size_t hstep = (size_t)HALF * K * 2;
    const size_t tstep = 2 * hstep;
    const unsigned ldsw = (unsigned)wid * 1024u;
    const int aoff = lds_byte(wr * 64 + fr, fq * 8), boff = lds_byte(wc * 32 + fr, fq * 8);
#define PG8_SA(b, h) (((b) * 2 + (h)) * HTB)
#define PG8_SB(b, h) ((4 + (b) * 2 + (h)) * HTB)
#define PG8_STAGE(bufoff, gbase, voff) do { _Pragma("unroll") for (int _i = 0; _i < 2; ++_i) \
        __builtin_amdgcn_global_load_lds((const unsigned*)((const char*)(gbase) + (voff)[_i]), (PG8_LAS unsigned*)(lds + (bufoff) + ldsw + _i * 8192), 16, 0, 0); } while (0)
#define PG8_LDA(dst, b, h) do { _Pragma("unroll") for (int m = 0; m < 4; ++m) _Pragma("unroll") for (int k = 0; k < 2; ++k) dst[m][k] = *(const PG8_LAS bf16x8*)(lds + PG8_SA(b, h) + aoff + m * 2048 + k * 1024); } while (0)
#define PG8_LDB(dst, b, h) do { _Pragma("unroll") for (int n = 0; n < 2; ++n) _Pragma("unroll") for (int k = 0; k < 2; ++k) dst[n][k] = *(const PG8_LAS bf16x8*)(lds + PG8_SB(b, h) + boff + n * 2048 + k * 1024); } while (0)
#define PG8_MMA(ai, bj, At, Bt) do { __builtin_amdgcn_s_setprio(1); _Pragma("unroll") for (int m = 0; m < 4; ++m) _Pragma("unroll") for (int n = 0; n < 2; ++n) _Pragma("unroll") for (int k = 0; k < 2; ++k) \
        acc[ai][bj][m][n] = __builtin_amdgcn_mfma_f32_16x16x32_bf16(Bt[n][k], At[m][k], acc[ai][bj][m][n], 0, 0, 0); __builtin_amdgcn_s_setprio(0); } while (0)
#define PG8_WAIT_V(n) asm volatile("s_waitcnt vmcnt(" #n ")" ::: "memory")
#define PG8_WAIT_L(n) asm volatile("s_waitcnt lgkmcnt(" #n ")" ::: "memory")
#define PG8_BAR __builtin_amdgcn_s_barrier()
#define PG8_SCHED __builtin_amdgcn_sched_barrier(0)
    Unit cur, nxt; int ui = 0;
    if (!S.next(0, cur)) return;
    f32x4 acc[2][2][4][2];
#pragma unroll
    for (int a = 0; a < 2; ++a)
#pragma unroll
        for (int b = 0; b < 2; ++b)
#pragma unroll
            for (int m = 0; m < 4; ++m)
#pragma unroll
                for (int n = 0; n < 2; ++n) acc[a][b][m][n] = (f32x4){0.f, 0.f, 0.f, 0.f};
    bf16x8 At[4][2], B0[2][2], B1[2][2];
    const char* cA = (const char*)g.A + (size_t)cur.pm * tstep; const char* cB = (const char*)g.Bt + (size_t)cur.pn * tstep;
    S.a_ready(cur);
    if constexpr (SP2) {
        PG8_STAGE(PG8_SB(0, 0), cB, voffB); PG8_STAGE(PG8_SB(0, 1), cB + hstep, voffB); PG8_STAGE(PG8_SA(0, 0), cA, voffA); PG8_STAGE(PG8_SA(0, 1), cA + hstep, voffA);
        if (wr == 1) PG8_BAR;
        PG8_WAIT_V(2); PG8_BAR;
        PG8_STAGE(PG8_SB(1, 0), cB + kstep, voffB); PG8_STAGE(PG8_SA(1, 0), cA + kstep, voffA); PG8_STAGE(PG8_SB(1, 1), cB + hstep + kstep, voffB);
        PG8_WAIT_V(6); PG8_BAR;
    } else {
        PG8_STAGE(PG8_SB(0, 0), cB, voffB); PG8_STAGE(PG8_SA(0, 0), cA, voffA); PG8_STAGE(PG8_SB(0, 1), cB + hstep, voffB); PG8_STAGE(PG8_SA(0, 1), cA + hstep, voffA);
        if (wr == 1) PG8_BAR;
        PG8_WAIT_V(4); PG8_BAR;
        PG8_STAGE(PG8_SB(1, 0), cB + kstep, voffB); PG8_STAGE(PG8_SA(1, 0), cA + kstep, voffA); PG8_STAGE(PG8_SB(1, 1), cB + hstep + kstep, voffB);
        PG8_WAIT_V(6); PG8_BAR;
    }
    for (;;) {
        const bool has_next = S.next(ui + 1, nxt);
        const char* nA = has_next ? (const char*)g.A + (size_t)nxt.pm * tstep : cA; const char* nB = has_next ? (const char*)g.Bt + (size_t)nxt.pn * tstep : cB;
        for (int t = 0; t < nt; t += 2) {
            const bool last = (t == nt - 2);
            const char* a1 = cA + (size_t)(t + 1) * kstep;
            const char* a2 = last ? nA : cA + (size_t)(t + 2) * kstep; const char* b2 = last ? nB : cB + (size_t)(t + 2) * kstep;
            const char* a3 = a2 + kstep; const char* b3 = b2 + kstep;
            if (last && has_next) S.a_ready(nxt);
            if constexpr (SP2) {
            PG8_LDB(B0, 0, 0); PG8_LDB(B1, 0, 1); PG8_SCHED; PG8_LDA(At, 0, 0); PG8_STAGE(PG8_SA(1, 1), a1 + hstep, voffA);
            PG8_WAIT_V(8); PG8_WAIT_L(0); PG8_BAR; PG8_MMA(0, 0, At, B0); PG8_MMA(0, 1, At, B1); PG8_BAR; PG8_SCHED;
            PG8_LDA(At, 0, 1); PG8_STAGE(PG8_SB(0, 0), b2, voffB); PG8_STAGE(PG8_SB(0, 1), b2 + hstep, voffB); PG8_STAGE(PG8_SA(0, 0), a2, voffA);
            PG8_WAIT_V(8); PG8_WAIT_L(0); PG8_BAR; PG8_MMA(1, 0, At, B0); PG8_MMA(1, 1, At, B1); PG8_BAR; PG8_SCHED;
            PG8_LDB(B0, 1, 0); PG8_LDB(B1, 1, 1); PG8_SCHED; PG8_LDA(At, 1, 0); PG8_STAGE(PG8_SA(0, 1), a2 + hstep, voffA);
            PG8_WAIT_V(8); PG8_WAIT_L(0); PG8_BAR; PG8_MMA(0, 0, At, B0); PG8_MMA(0, 1, At, B1); PG8_BAR; PG8_SCHED;
            PG8_LDA(At, 1, 1); PG8_STAGE(PG8_SB(1, 0), b3, voffB); PG8_STAGE(PG8_SB(1, 1), b3 + hstep, voffB); PG8_STAGE(PG8_SA(1, 0), a3, voffA);
            PG8_WAIT_V(8); PG8_WAIT_L(0); PG8_BAR; PG8_MMA(1, 0, At, B0); PG8_MMA(1, 1, At, B1); PG8_BAR; PG8_SCHED;
            } else {
            PG8_LDB(B0, 0, 0); PG8_SCHED; PG8_LDA(At, 0, 0); PG8_STAGE(PG8_SA(1, 1), a1 + hstep, voffA);
            PG8_WAIT_L(8); PG8_BAR; PG8_WAIT_L(0); PG8_MMA(0, 0, At, B0); PG8_BAR; PG8_SCHED;
            PG8_LDB(B1, 0, 1); PG8_STAGE(PG8_SB(0, 0), b2, voffB);
            PG8_BAR; PG8_WAIT_L(0); PG8_MMA(0, 1, At, B1); PG8_BAR;
            PG8_LDA(At, 0, 1); PG8_STAGE(PG8_SA(0, 0), a2, voffA);
            PG8_BAR; PG8_WAIT_L(0); PG8_MMA(1, 0, At, B0); PG8_BAR; PG8_SCHED;
            PG8_STAGE(PG8_SB(0, 1), b2 + hstep, voffB);
            PG8_WAIT_V(6); PG8_BAR; PG8_MMA(1, 1, At, B1); PG8_BAR;
            PG8_LDB(B0, 1, 0); PG8_SCHED; PG8_LDA(At, 1, 0); PG8_STAGE(PG8_SA(0, 1), a2 + hstep, voffA);
            PG8_WAIT_L(8); PG8_BAR; PG8_WAIT_L(0); PG8_MMA(0, 0, At, B0); PG8_BAR; PG8_SCHED;
            PG8_LDB(B1, 1, 1); PG8_STAGE(PG8_SB(1, 0), b3, voffB);
            PG8_BAR; PG8_WAIT_L(0); PG8_MMA(0, 1, At, B1); PG8_BAR;
            PG8_LDA(At, 1, 1); PG8_STAGE(PG8_SA(1, 0), a3, voffA);
            PG8_BAR; PG8_WAIT_L(0); PG8_MMA(1, 0, At, B0); PG8_BAR; PG8_SCHED;
            PG8_STAGE(PG8_SB(1, 1), b3 + hstep, voffB);
            PG8_WAIT_V(6); PG8_BAR; PG8_MMA(1, 1, At, B1); PG8_BAR;
            }
        }
        if constexpr (ALIGN_EPI) { if (wr == 0) PG8_BAR; }
        if constexpr (!Epi::AFTER_DRAIN) { E(acc, cur, wr, wc, fr, fq); S.done(cur); }
        if (!has_next) break;
#pragma unroll
        for (int a = 0; a < 2; ++a)
#pragma unroll
            for (int b = 0; b < 2; ++b)
#pragma unroll
                for (int m = 0; m < 4; ++m)
#pragma unroll
                    for (int n = 0; n < 2; ++n) acc[a][b][m][n] = (f32x4){0.f, 0.f, 0.f, 0.f};
        cur = nxt; cA = nA; cB = nB; ++ui;
        if constexpr (ALIGN_EPI) { if (wr == 1) PG8_BAR; }
    }
    PG8_WAIT_V(0);
    if constexpr (!ALIGN_EPI) { if (wr == 0) PG8_BAR; }
    PG8_BAR;
    if constexpr (Epi::AFTER_DRAIN) { E.fused(acc, cur, wr, wc, fr, fq, lds, wid, lane); S.done(cur); }
#undef PG8_SA
#undef PG8_SB
#undef PG8_STAGE
#undef PG8_LDA
#undef PG8_LDB
#undef PG8_MMA
#undef PG8_WAIT_V
#undef PG8_WAIT_L
#undef PG8_BAR
#undef PG8_SCHED
}
}
#ifndef PG8_SP2
#define PG8_SP2 true
#endif
#ifndef PG8_ALIGN
#define PG8_ALIGN true
#endif
constexpr int NWAVES = 8;
constexpr int NBATCH = 4, SEQ = 4096, DM = 2048, M = NBATCH * SEQ;
constexpr int HD = 128, NHG = 8;
constexpr int NATT = 6144, ATT_SRC_LD = 6152;
constexpr int FF = 5632, NE = 8, FFE = 2816;
constexpr float RMS_EPS = 1e-6f;
constexpr float LOG2E = 1.4426950408889634f;
constexpr float QSCALE = 0.08838834764831845f * 1.4426950408889634f;

#ifndef MK_ONE_LAUNCH
#define MK_ONE_LAUNCH 1
#endif
constexpr int PH_PER_LP = 28;
constexpr int NPHASES = 1 + 2 * PH_PER_LP + 1;
constexpr bool ONE_LAUNCH = (MK_ONE_LAUNCH != 0);

constexpr size_t MiB = 1u << 20;
constexpr size_t WS_CTL = 0, CTL_ZERO_BYTES = 1 * MiB;
constexpr size_t SZ_AIN = 24 * MiB, SZ_SQ = 8 * MiB, SZ_GU = 44 * MiB, SZ_DN = 22 * MiB, SZ_MGU = 22 * MiB, SZ_MDN = 11 * MiB;
constexpr size_t WS_AIN = 1 * MiB;
constexpr size_t WS_AOUT = WS_AIN + 2 * SZ_AIN;
constexpr size_t WS_CIN = WS_AOUT + 2 * SZ_SQ;
constexpr size_t WS_COUT = WS_CIN + 2 * SZ_AIN;
constexpr size_t WS_GU = WS_COUT + 2 * SZ_SQ;
constexpr size_t WS_DN = WS_GU + 2 * SZ_GU;
constexpr size_t WS_MGU = WS_DN + 2 * SZ_DN;
constexpr size_t WS_MDN = WS_MGU + 16 * SZ_MGU;
constexpr size_t WS_H = WS_MDN + 16 * SZ_MDN;
constexpr size_t WS_QKV = WS_H + 64 * MiB;
constexpr size_t WS_O = WS_QKV + 192 * MiB;
constexpr size_t WS_ACT = WS_O + 64 * MiB;
constexpr size_t WS_SMALL = WS_ACT + 192 * MiB;
constexpr size_t WS_LOGF = WS_SMALL;
constexpr size_t WS_C2 = WS_SMALL + 1 * MiB;
constexpr size_t WS_COMB = WS_SMALL + 2 * MiB;
constexpr size_t WS_END = WS_SMALL + 16 * MiB;
constexpr int CW_TMO = 0, CW_CODE = 1, CW_BAR = 4096;

constexpr int RING_OFF = 0, RING_BYTES = 131072;
constexpr int LDSCTL_OFF = RING_BYTES, MISC_OFF = LDSCTL_OFF + 320;
constexpr int LDS_BYTES = 147456;
#define GAS __attribute__((address_space(1)))
#define LAS __attribute__((address_space(3)))
typedef unsigned short bf16;
typedef unsigned v4u __attribute__((ext_vector_type(4)));
typedef float f32x4 __attribute__((ext_vector_type(4)));
typedef short bf16x8 __attribute__((ext_vector_type(8)));
typedef GAS unsigned gu32;
typedef GAS unsigned long long gu64;
#define RLX_AGENT __ATOMIC_RELAXED, __HIP_MEMORY_SCOPE_AGENT
#define LDS_WAIT() asm volatile("s_waitcnt lgkmcnt(0)" ::: "memory")
#define VM_WAIT() asm volatile("s_waitcnt vmcnt(0)" ::: "memory")
__device__ __forceinline__ unsigned long long rt() { return __builtin_amdgcn_s_memrealtime(); }
__device__ __forceinline__ unsigned f2bf(float f) { unsigned u = __builtin_bit_cast(unsigned, f); return (u + 0x7fffu + ((u >> 16) & 1u)) >> 16; }
__device__ __forceinline__ unsigned pk2(float lo, float hi) { return f2bf(lo) | (f2bf(hi) << 16); }

#define XB_TMO      128
#define XB_XCNT(j)  (256  + 64 * (j))
#define XB_XSUB(j)  (1280 + 64 * (j))
#define XB_XGEN(j)  (2304 + 64 * (j))
#define XB_TOP      3328
#define XB_TOPGEN   3392
#define XCD_BAR_WORDS 3456
#define XB_SPIN_CAP (1u << 24)

__device__ __forceinline__ unsigned xb_ld(unsigned* p)              { return __hip_atomic_load(p, __ATOMIC_RELAXED, __HIP_MEMORY_SCOPE_AGENT); }
__device__ __forceinline__ unsigned xb_add(unsigned* p, unsigned v) { return __hip_atomic_fetch_add(p, v, __ATOMIC_RELAXED, __HIP_MEMORY_SCOPE_AGENT); }
__device__ __forceinline__ unsigned xb_xcc_id() { return (unsigned)__builtin_amdgcn_s_getreg((3 << 11) | 20) & 0xFu; }
#define XB_SPIN(cond, bar) do { unsigned _sp = 0; while (cond) { __builtin_amdgcn_s_sleep(1); \
    if ((++_sp & 255u) == 0u) { if (xb_ld(&(bar)[XB_TMO])) break; if (_sp > XB_SPIN_CAP) { atomicAdd(&(bar)[XB_TMO], 1u); break; } } } } while (0)

struct XcdBarrier {
    unsigned* bar; unsigned x;
    volatile LAS unsigned* st;
};

__device__ __forceinline__ XcdBarrier xcd_barrier_post(unsigned* bar, volatile LAS unsigned* st) {
    XcdBarrier b; b.bar = bar; b.x = xb_xcc_id(); b.st = st;
    if (threadIdx.x == 0) (void)xb_add(&bar[XB_XCNT(b.x)], 1u);
    return b;
}
__device__ __forceinline__ void xcd_barrier_complete(unsigned* bar, unsigned x, unsigned& nloc, unsigned& nx) {
    const unsigned G = gridDim.x * gridDim.y * gridDim.z;
    unsigned sum, cnt, mine, sp = 0u;
    for (;;) {
        sum = 0u; cnt = 0u; mine = 0u;
#pragma unroll
        for (unsigned j = 0; j < 16; ++j) { const unsigned c = xb_ld(&bar[XB_XCNT(j)]); sum += c; cnt += (c > 0u) ? 1u : 0u; mine = (j == x) ? c : mine; }
        if (sum == G) break;
        __builtin_amdgcn_s_sleep(1);
        if ((++sp & 255u) == 0u) { if (xb_ld(&bar[XB_TMO])) break; if (sp > XB_SPIN_CAP) { atomicAdd(&bar[XB_TMO], 1u); break; } }
    }
    nloc = mine > 0u ? mine : 1u; nx = cnt > 0u ? cnt : 1u;
}

__device__ __forceinline__ void xcd_barrier(const XcdBarrier& b) {
    asm volatile("s_waitcnt vmcnt(0)" ::: "memory");
    __syncthreads();
    if (threadIdx.x == 0) {
        unsigned* bar = b.bar;
        __builtin_amdgcn_s_waitcnt(0);
        unsigned nloc = b.st[0], nx = b.st[1];
        if (nloc == 0u) { xcd_barrier_complete(bar, b.x, nloc, nx); b.st[0] = nloc; b.st[1] = nx; }
        const unsigned old = xb_add(&bar[XB_XSUB(b.x)], 1u);
        const unsigned gen = old / nloc;
        if (old + 1u == (gen + 1u) * nloc) {
            __builtin_amdgcn_fence(__ATOMIC_RELEASE, "agent");
            asm volatile("s_waitcnt vmcnt(0)" ::: "memory");
            const unsigned og = xb_add(&bar[XB_TOP], 1u);
            const unsigned tg = og / nx;
            if (og + 1u == (tg + 1u) * nx) xb_add(&bar[XB_TOPGEN], 1u);
            else XB_SPIN(xb_ld(&bar[XB_TOPGEN]) == tg, bar);
            __builtin_amdgcn_fence(__ATOMIC_ACQUIRE, "agent");
            xb_add(&bar[XB_XGEN(b.x)], 1u);
            asm volatile("s_waitcnt vmcnt(0)" ::: "memory");
        } else {
            XB_SPIN(xb_ld(&bar[XB_XGEN(b.x)]) == gen, bar);
            __builtin_amdgcn_fence(__ATOMIC_ACQUIRE, "agent");
            asm volatile("s_waitcnt vmcnt(0)" ::: "memory");
        }
    }
    __syncthreads();
}


__device__ __forceinline__ float wave_sum(float v) {
#pragma unroll
    for (int o = 1; o < 64; o <<= 1) v += __shfl_xor(v, o);
    return v;
}
__device__ __forceinline__ float wave_max(float v) {
#pragma unroll
    for (int o = 1; o < 64; o <<= 1) v = fmaxf(v, __shfl_xor(v, o));
    return v;
}
__device__ __forceinline__ float bf2f(unsigned short b) { return __uint_as_float((unsigned)b << 16); }
__device__ __forceinline__ float bflo(unsigned w) { return __uint_as_float(w << 16); }
__device__ __forceinline__ float bfhi(unsigned w) { return __uint_as_float(w & 0xffff0000u); }

__device__ __forceinline__ void tr_item(const float* W, int ldw, int K, bf16* WT, int kb, int src_col, int dst_row, float scale, LAS float* scr, int lane) {
    const int k0 = 64 * kb;
#pragma unroll 8
    for (int i = 0; i < 32; ++i) { const int kk = 2 * i + (lane >> 5); scr[kk * 33 + (lane & 31)] = W[(size_t)(k0 + kk) * ldw + src_col + (lane & 31)]; }
    LDS_WAIT(); asm volatile("" ::: "memory");
    const int c = lane & 7;
#pragma unroll
    for (int j = 0; j < 4; ++j) { const int n = (lane >> 3) + 8 * j; const LAS float* s = scr + (8 * c) * 33 + n;
        v4u o; o.x = pk2(s[0 * 33] * scale, s[1 * 33] * scale); o.y = pk2(s[2 * 33] * scale, s[3 * 33] * scale); o.z = pk2(s[4 * 33] * scale, s[5 * 33] * scale); o.w = pk2(s[6 * 33] * scale, s[7 * 33] * scale);
        *(GAS v4u*)(WT + (size_t)(dst_row + n) * K + k0 + 8 * c) = o; }
    LDS_WAIT(); asm volatile("" ::: "memory");
}
struct Args { const float* in[17]; float* out; unsigned char* ws; int ph_lo, ph_hi, li, pad; };
typedef const __attribute__((address_space(4))) Args* kargs_t;
__device__ __forceinline__ kargs_t kargs() { unsigned long long p = (unsigned long long)__builtin_amdgcn_kernarg_segment_ptr(); asm volatile("" : "+s"(p)); return (kargs_t)p; }
enum { I_X = 0, I_MIXN, I_FFNN, I_FINN, I_WINATT, I_BFORGET, I_WOUTATT, I_WINCONV, I_CONVW, I_WOUTCONV, I_WGD, I_WUD, I_WDD, I_WROUTER, I_WGM, I_WUM, I_WDM };
constexpr int IT_AIN = 32 * 192, IT_SQ = 32 * 64, IT_FF = 32 * 176, IT_DN = 88 * 64, IT_ME = 32 * 88, IT_MD = 44 * 64;
constexpr int IT_PER_J = 2 * IT_AIN + 2 * IT_SQ + 2 * IT_FF + IT_DN + NE * (2 * IT_ME + IT_MD);
__device__ __forceinline__ void p0_item(int it, LAS float* scr, int lane) {
    const kargs_t KA = kargs(); unsigned char* ws = KA->ws;
    const int j = it / IT_PER_J; int r = it - j * IT_PER_J;
    if (r < IT_AIN) { const int kb = r / 192, nb = r % 192; const bool isq = (nb < 32) || (nb >= 96 && nb < 128);
        tr_item(KA->in[I_WINATT] + (size_t)j * DM * ATT_SRC_LD, ATT_SRC_LD, DM, (bf16*)(ws + WS_AIN + j * SZ_AIN), kb, 32 * nb + (nb >= 96 ? 8 : 0), 32 * nb, isq ? QSCALE : 1.0f, scr, lane); return; } r -= IT_AIN;
    if (r < IT_SQ) { const int kb = r / 64, nb = r % 64;
        tr_item(KA->in[I_WOUTATT] + (size_t)j * DM * DM, DM, DM, (bf16*)(ws + WS_AOUT + j * SZ_SQ), kb, 32 * nb, 32 * nb, 1.0f, scr, lane); return; } r -= IT_SQ;
    if (r < IT_AIN) { const int kb = r / 192, nb = r % 192;
        tr_item(KA->in[I_WINCONV] + (size_t)j * DM * 3 * DM, 3 * DM, DM, (bf16*)(ws + WS_CIN + j * SZ_AIN), kb, 32 * nb, 32 * nb, 1.0f, scr, lane); return; } r -= IT_AIN;
    if (r < IT_SQ) { const int kb = r / 64, nb = r % 64;
        tr_item(KA->in[I_WOUTCONV] + (size_t)j * DM * DM, DM, DM, (bf16*)(ws + WS_COUT + j * SZ_SQ), kb, 32 * nb, 32 * nb, 1.0f, scr, lane); return; } r -= IT_SQ;
    if (r < 2 * IT_FF) { const int up = r >= IT_FF; if (up) r -= IT_FF; const int kb = r / 176, nb = r % 176, n0 = 32 * nb;
        tr_item((up ? KA->in[I_WUD] : KA->in[I_WGD]) + (size_t)j * DM * FF, FF, DM, (bf16*)(ws + WS_GU + j * SZ_GU), kb, n0, (n0 >> 7) * 256 + (up ? 128 : 0) + (n0 & 127), 1.0f, scr, lane); return; } r -= 2 * IT_FF;
    if (r < IT_DN) { const int kb = r / 64, nb = r % 64;
        tr_item(KA->in[I_WDD] + (size_t)j * FF * DM, DM, FF, (bf16*)(ws + WS_DN + j * SZ_DN), kb, 32 * nb, 32 * nb, 1.0f, scr, lane); return; } r -= IT_DN;
    const int e = r / (2 * IT_ME + IT_MD); r -= e * (2 * IT_ME + IT_MD); const int je = j * NE + e;
    if (r < 2 * IT_ME) { const int up = r >= IT_ME; if (up) r -= IT_ME; const int kb = r / 88, nb = r % 88, n0 = 32 * nb;
        tr_item((up ? KA->in[I_WUM] : KA->in[I_WGM]) + (size_t)je * DM * FFE, FFE, DM, (bf16*)(ws + WS_MGU + je * SZ_MGU), kb, n0, (n0 >> 7) * 256 + (up ? 128 : 0) + (n0 & 127), 1.0f, scr, lane); return; } r -= 2 * IT_ME;
    { const int kb = r / 64, nb = r % 64;
        tr_item(KA->in[I_WDM] + (size_t)je * FFE * DM, DM, FFE, (bf16*)(ws + WS_MDN + je * SZ_MDN), kb, 32 * nb, 32 * nb, 1.0f, scr, lane); }
}

template <int MODE>
__device__ __forceinline__ void norm_phase(LAS unsigned char* lds, int gw, int NGW, int lane, int tid, const float* xin, const float* gain, bf16* H, float* fout,
                                           const float* W8src, int w8ld, const float* bias8, float* ex_out) {
    LAS float* W8t = (LAS float*)lds;
    if (MODE == 1 || MODE == 2) {
        for (int k = tid; k < DM; k += NWAVES * 64) { const f32x4 a = *(const f32x4*)(W8src + (size_t)k * w8ld), b = *(const f32x4*)(W8src + (size_t)k * w8ld + 4);
            W8t[0 * DM + k] = a.x; W8t[1 * DM + k] = a.y; W8t[2 * DM + k] = a.z; W8t[3 * DM + k] = a.w; W8t[4 * DM + k] = b.x; W8t[5 * DM + k] = b.y; W8t[6 * DM + k] = b.z; W8t[7 * DM + k] = b.w; }
        __syncthreads();
    }
    f32x4 gv[8];
#pragma unroll
    for (int j = 0; j < 8; ++j) gv[j] = ((const f32x4*)gain)[lane + 64 * j];
    for (int row = gw; row < M; row += NGW) {
        const f32x4* xr = (const f32x4*)(xin + (size_t)row * DM) + lane;
        f32x4 v[8]; float s = 0.f;
#pragma unroll
        for (int j = 0; j < 8; ++j) { v[j] = xr[64 * j]; s += (v[j].x * v[j].x + v[j].y * v[j].y) + (v[j].z * v[j].z + v[j].w * v[j].w); }
        const float inv = 1.0f / sqrtf(wave_sum(s) * (1.0f / DM) + RMS_EPS);
#pragma unroll
        for (int j = 0; j < 8; ++j) v[j] = (v[j] * inv) * gv[j];
        if (MODE != 3) { unsigned long long* o8 = (unsigned long long*)(H + (size_t)row * DM) + lane;
#pragma unroll
            for (int j = 0; j < 8; ++j) o8[64 * j] = (unsigned long long)pk2(v[j].x, v[j].y) | ((unsigned long long)pk2(v[j].z, v[j].w) << 32); }
        else { f32x4* o = (f32x4*)(fout + (size_t)row * DM) + lane;
#pragma unroll
            for (int j = 0; j < 8; ++j) o[64 * j] = v[j]; }
        if (MODE == 1 || MODE == 2) {
            float val = 0.f;
#pragma unroll 1
            for (int c = 0; c < 8; ++c) { float a = 0.f;
#pragma unroll
                for (int j = 0; j < 8; ++j) { const f32x4 w = *(const LAS f32x4*)(W8t + c * DM + 4 * (lane + 64 * j)); a += (v[j].x * w.x + v[j].y * w.y) + (v[j].z * w.z + v[j].w * w.w); }
                a = wave_sum(a); val = (lane == c) ? a : val; }
            if (MODE == 1) {
                if (lane < 8) { const float t = val + bias8[lane]; const float ls = -(fmaxf(-t, 0.f) + log1pf(expf(-fabsf(t)))); ex_out[(size_t)row * 8 + lane] = ls * LOG2E; }
            } else {
                float p[8];
#pragma unroll
                for (int c = 0; c < 8; ++c) p[c] = __shfl(val, c);
                int e1 = 0; float v1 = p[0];
#pragma unroll
                for (int c = 1; c < 8; ++c) if (p[c] > v1) { v1 = p[c]; e1 = c; }
                int e2 = -1; float v2 = -__builtin_inff();
#pragma unroll
                for (int c = 0; c < 8; ++c) if (c != e1 && p[c] > v2) { v2 = p[c]; e2 = c; }
                const float t = expf(v2 - v1), g1 = 1.0f / (1.0f + t), g2 = t / (1.0f + t);
                if (lane < 8) ex_out[(size_t)row * 8 + lane] = (lane == e1) ? g1 : ((lane == e2) ? g2 : 0.f);
            }
        }
    }
}

__device__ __forceinline__ void cumsum_seq(const float* logf, float* c2, int bh, int lane) {
    const int b = bh >> 3, h = bh & 7;
    const float* lf = logf + (size_t)(b * SEQ) * 8 + h;
    float loc = 0.f;
    for (int i = 0; i < 64; ++i) loc += lf[(size_t)(64 * lane + i) * 8];
    float incl = loc;
#pragma unroll
    for (int off = 1; off < 64; off <<= 1) { const float y = __shfl_up(incl, off); if (lane >= off) incl += y; }
    float run = incl - loc;
    for (int i = 0; i < 64; ++i) { run += lf[(size_t)(64 * lane + i) * 8]; c2[(size_t)bh * SEQ + 64 * lane + i] = run; }
}

__device__ __forceinline__ void attn_row(const bf16* QKV, const float* c2, bf16* O, int b, int hh, int t, LAS float* qs, LAS float* ps, int lane) {
    const bool fox = hh < 8; const int h = hh & 7;
    const int qcol = (fox ? 0 : 3072) + h * HD, kcol = qcol + 1024, vcol = qcol + 2048;
    const bf16* qp = QKV + (size_t)(b * SEQ + t) * NATT + qcol;
    qs[lane] = bf2f(qp[lane]); qs[lane + 64] = bf2f(qp[lane + 64]);
    LDS_WAIT(); asm volatile("" ::: "memory");
    float m = -1e30f, l = 0.f, o0 = 0.f, o1 = 0.f, R = 0.f;
    const float* cs = c2 + (size_t)(b * 8 + h) * SEQ;
    const float ct = fox ? cs[t] : 0.f;
    for (int kb = t & ~63; kb >= 0; kb -= 64) {
        const int key = kb + lane;
        const bf16* kp = QKV + (size_t)(b * SEQ + key) * NATT + kcol;
        float z = 0.f;
#pragma unroll
        for (int d8 = 0; d8 < 16; ++d8) { const v4u kv = *(const v4u*)(kp + d8 * 8); const f32x4 qa = *(const LAS f32x4*)(qs + d8 * 8), qb = *(const LAS f32x4*)(qs + d8 * 8 + 4);
            z += (bflo(kv.x) * qa.x + bfhi(kv.x) * qa.y) + (bflo(kv.y) * qa.z + bfhi(kv.y) * qa.w) + (bflo(kv.z) * qb.x + bfhi(kv.z) * qb.y) + (bflo(kv.w) * qb.z + bfhi(kv.w) * qb.w); }
        float p;
        if (fox) {
            const bool valid = key <= t;
            const float lg = valid ? z + (ct - cs[key]) : -__builtin_inff();
            const float mn = fmaxf(m, wave_max(lg));
            p = __builtin_amdgcn_exp2f(lg - mn);
            const float alpha = __builtin_amdgcn_exp2f(m - mn);
            l = l * alpha + wave_sum(p); o0 *= alpha; o1 *= alpha; m = mn;
        } else {
            const bool valid = key < t;
            const float u = __builtin_amdgcn_logf(1.0f + __builtin_amdgcn_exp2f(-fabsf(z)));
            const float lomneg = fmaxf(z, 0.f) + u;
            const float lom = valid ? -lomneg : 0.f, lb = z - lomneg;
            float incl = lom;
#pragma unroll
            for (int off = 1; off < 64; off <<= 1) { const float y = __shfl_down(incl, off); if (lane + off < 64) incl += y; }
            const float la = lb + R + (incl - lom);
            p = valid ? __builtin_amdgcn_exp2f(la) : 0.f;
            R += __shfl(incl, 0);
        }
        ps[lane] = p;
        LDS_WAIT(); asm volatile("" ::: "memory");
        const bf16* vp = QKV + (size_t)(b * SEQ + kb) * NATT + vcol + 2 * lane;
#pragma unroll 8
        for (int k = 0; k < 64; ++k) { const float pk = ps[k]; const unsigned vv = *(const unsigned*)(vp + (size_t)k * NATT); o0 += pk * bflo(vv); o1 += pk * bfhi(vv); }
        LDS_WAIT(); asm volatile("" ::: "memory");
    }
    if (fox) { const float il = 1.0f / l; o0 *= il; o1 *= il; }
    *(unsigned*)(O + (size_t)(b * SEQ + t) * DM + (fox ? 0 : 1024) + h * HD + 2 * lane) = pk2(o0, o1);
}
__device__ __forceinline__ void attn_simple_phase(LAS unsigned char* lds, const bf16* QKV, const float* c2, bf16* O, int gw, int NGW, int wave, int lane) {
    LAS float* qs = (LAS float*)(lds + wave * 1024); LAS float* ps = qs + 128;
    for (int p = gw; p < 64 * (SEQ / 2); p += NGW) {
        const int bh = p / (SEQ / 2), j = p % (SEQ / 2);
        attn_row(QKV, c2, O, bh >> 4, bh & 15, j, qs, ps, lane);
        attn_row(QKV, c2, O, bh >> 4, bh & 15, SEQ - 1 - j, qs, ps, lane);
    }
}

__device__ __forceinline__ void unpack8(const v4u w, float (&f)[8]) { f[0] = bflo(w.x); f[1] = bfhi(w.x); f[2] = bflo(w.y); f[3] = bfhi(w.y); f[4] = bflo(w.z); f[5] = bfhi(w.z); f[6] = bflo(w.w); f[7] = bfhi(w.w); }
__device__ __forceinline__ void conv_phase(const bf16* P3, const float* cw, bf16* Y, int gt, int NGT) {
    for (int item = gt; item < (M / 16) * 256; item += NGT) {
        const int cg = item & 255, ci = item >> 8, c0 = cg * 8, t0 = ci * 16;
        float w0[8], w1[8], w2[8];
#pragma unroll
        for (int i = 0; i < 8; ++i) { w0[i] = cw[c0 + i]; w1[i] = cw[DM + c0 + i]; w2[i] = cw[2 * DM + c0 + i]; }
        float gm2[8], gm1[8];
#pragma unroll
        for (int i = 0; i < 8; ++i) { gm2[i] = 0.f; gm1[i] = 0.f; }
        if ((t0 & (SEQ - 1)) != 0) {
            float a[8], b[8];
            unpack8(*(const v4u*)(P3 + (size_t)(t0 - 2) * NATT + DM + c0), a); unpack8(*(const v4u*)(P3 + (size_t)(t0 - 2) * NATT + 2 * DM + c0), b);
#pragma unroll
            for (int i = 0; i < 8; ++i) gm2[i] = a[i] * b[i];
            unpack8(*(const v4u*)(P3 + (size_t)(t0 - 1) * NATT + DM + c0), a); unpack8(*(const v4u*)(P3 + (size_t)(t0 - 1) * NATT + 2 * DM + c0), b);
#pragma unroll
            for (int i = 0; i < 8; ++i) gm1[i] = a[i] * b[i];
        }
        for (int r = 0; r < 16; ++r) {
            const size_t row = (size_t)(t0 + r);
            float gb[8], gc[8], gu[8], y[8];
            unpack8(*(const v4u*)(P3 + row * NATT + c0), gb); unpack8(*(const v4u*)(P3 + row * NATT + DM + c0), gc); unpack8(*(const v4u*)(P3 + row * NATT + 2 * DM + c0), gu);
#pragma unroll
            for (int i = 0; i < 8; ++i) { const float g = gc[i] * gu[i]; y[i] = gb[i] * (w0[i] * gm2[i] + w1[i] * gm1[i] + w2[i] * g); gm2[i] = gm1[i]; gm1[i] = g; }
            v4u o; o.x = pk2(y[0], y[1]); o.y = pk2(y[2], y[3]); o.z = pk2(y[4], y[5]); o.w = pk2(y[6], y[7]);
            *(v4u*)(Y + row * DM + c0) = o;
        }
    }
}

#define WSP(off) (kargs()->ws + (off))
__global__ void __launch_bounds__(NWAVES * 64, 2) mega_fwd(Args args_unused) {
    extern __shared__ __attribute__((aligned(16))) unsigned char lds_raw[];
    LAS unsigned char* lds = (LAS unsigned char*)lds_raw;
    volatile LAS unsigned* MISC = (volatile LAS unsigned*)(lds + MISC_OFF);
#define TID_DECL int tid = threadIdx.x; asm volatile("" : "+v"(tid)); const int lane = tid & 63, wave = __builtin_amdgcn_readfirstlane(tid >> 6); const int G = gridDim.x, gw = blockIdx.x * NWAVES + wave, NGW = G * NWAVES; (void)lane; (void)gw; (void)NGW; (void)G
    { TID_DECL;
    for (int u = tid; u < (LDS_BYTES - LDSCTL_OFF) / 4; u += NWAVES * 64) ((LAS unsigned*)(lds + LDSCTL_OFF))[u] = 0u;
    __syncthreads(); }
    XcdBarrier bar; bar.bar = (unsigned*)(WSP(WS_CTL)) + CW_BAR; bar.x = 0; bar.st = nullptr;
    if (ONE_LAUNCH) bar = xcd_barrier_post((unsigned*)(WSP(WS_CTL)) + CW_BAR, MISC + 8);
    const int G = gridDim.x;
#define GRID_BAR() do { if (ONE_LAUNCH) { xcd_barrier(bar); } } while (0)
    const int lo = kargs()->ph_lo, hi = kargs()->ph_hi;
#define IN(k) (lo <= (k) && (k) < hi)
#define BOTH(k) (IN(k) && IN((k) + 1))
#define GEMM_PHASE(EPI, Aptr, Bptr, N_, K_, Eobj) do { pg8::Gemm g{(const pg8::bf16_t*)(Aptr), (const pg8::bf16_t*)(Bptr), M, (N_), (K_)}; pg8::StaticOrder S; S.init(M, (N_), G, (int)blockIdx.x); \
        pg8::gemm_phase<EPI, pg8::StaticOrder, PG8_ALIGN, PG8_SP2>(lds + RING_OFF, g, S, Eobj); } while (0)

    if (IN(0)) { TID_DECL;
        LAS float* scr = (LAS float*)(lds + RING_OFF + wave * 16384);
        for (int it = gw; it < 2 * IT_PER_J; it += NGW) p0_item(it, scr, lane);
        if (BOTH(0)) GRID_BAR();
    }
    for (int lp = 0; lp < 2; ++lp) {
        const int pb = 1 + lp * PH_PER_LP, la = 2 * lp, lc = 2 * lp + 1;
        if (IN(pb + 0)) { TID_DECL;
            const kargs_t KA = kargs();
            norm_phase<1>(lds, gw, NGW, lane, tid, lp == 0 ? KA->in[I_X] : KA->out, KA->in[I_MIXN] + (size_t)la * DM, (bf16*)(KA->ws + WS_H), nullptr,
                          KA->in[I_WINATT] + (size_t)lp * DM * ATT_SRC_LD + 3072, ATT_SRC_LD, KA->in[I_BFORGET] + lp * 8, (float*)(KA->ws + WS_LOGF));
            if (BOTH(pb + 0)) GRID_BAR();
        }
        if (IN(pb + 1)) {
            { TID_DECL; if (blockIdx.x < 32 && wave == 0) cumsum_seq((const float*)WSP(WS_LOGF), (float*)WSP(WS_C2), blockIdx.x, lane); }
            pg8::EpiPlainBf16 E{(pg8::bf16_t*)WSP(WS_QKV), NATT};
            GEMM_PHASE(pg8::EpiPlainBf16, WSP(WS_H), WSP(WS_AIN + lp * SZ_AIN), NATT, DM, E);
            if (BOTH(pb + 1)) GRID_BAR();
        }
        if (IN(pb + 2)) { TID_DECL;
            attn_simple_phase(lds, (const bf16*)WSP(WS_QKV), (const float*)WSP(WS_C2), (bf16*)WSP(WS_O), gw, NGW, wave, lane);
            if (BOTH(pb + 2)) GRID_BAR();
        }
        if (IN(pb + 3)) {
            const kargs_t KA = kargs();
            pg8::EpiRes E{lp == 0 ? KA->in[I_X] : KA->out, KA->out, DM, nullptr, 0};
            GEMM_PHASE(pg8::EpiRes, WSP(WS_O), WSP(WS_AOUT + lp * SZ_SQ), DM, DM, E);
            if (BOTH(pb + 3)) GRID_BAR();
        }
        if (IN(pb + 4)) { TID_DECL;
            const kargs_t KA = kargs();
            norm_phase<0>(lds, gw, NGW, lane, tid, KA->out, KA->in[I_FFNN] + (size_t)la * DM, (bf16*)(KA->ws + WS_H), nullptr, nullptr, 0, nullptr, nullptr);
            if (BOTH(pb + 4)) GRID_BAR();
        }
        if (IN(pb + 5)) {
            pg8::EpiSwiGLU E{(pg8::bf16_t*)WSP(WS_ACT), FF};
            GEMM_PHASE(pg8::EpiSwiGLU, WSP(WS_H), WSP(WS_GU + lp * SZ_GU), 2 * FF, DM, E);
            if (BOTH(pb + 5)) GRID_BAR();
        }
        if (IN(pb + 6)) {
            const kargs_t KA = kargs();
            pg8::EpiRes E{KA->out, KA->out, DM, nullptr, 0};
            GEMM_PHASE(pg8::EpiRes, WSP(WS_ACT), WSP(WS_DN + lp * SZ_DN), DM, FF, E);
            if (BOTH(pb + 6)) GRID_BAR();
        }
        if (IN(pb + 7)) { TID_DECL;
            const kargs_t KA = kargs();
            norm_phase<0>(lds, gw, NGW, lane, tid, KA->out, KA->in[I_MIXN] + (size_t)lc * DM, (bf16*)(KA->ws + WS_H), nullptr, nullptr, 0, nullptr, nullptr);
            if (BOTH(pb + 7)) GRID_BAR();
        }
        if (IN(pb + 8)) {
            pg8::EpiPlainBf16 E{(pg8::bf16_t*)WSP(WS_QKV), NATT};
            GEMM_PHASE(pg8::EpiPlainBf16, WSP(WS_H), WSP(WS_CIN + lp * SZ_AIN), NATT, DM, E);
            if (BOTH(pb + 8)) GRID_BAR();
        }
        if (IN(pb + 9)) { TID_DECL;
            const kargs_t KA = kargs();
            conv_phase((const bf16*)(KA->ws + WS_QKV), KA->in[I_CONVW] + (size_t)lp * 3 * DM, (bf16*)(KA->ws + WS_O), blockIdx.x * NWAVES * 64 + tid, G * NWAVES * 64);
            if (BOTH(pb + 9)) GRID_BAR();
        }
        if (IN(pb + 10)) {
            const kargs_t KA = kargs();
            pg8::EpiRes E{KA->out, KA->out, DM, nullptr, 0};
            GEMM_PHASE(pg8::EpiRes, WSP(WS_O), WSP(WS_COUT + lp * SZ_SQ), DM, DM, E);
            if (BOTH(pb + 10)) GRID_BAR();
        }
        if (IN(pb + 11)) { TID_DECL;
            const kargs_t KA = kargs();
            norm_phase<2>(lds, gw, NGW, lane, tid, KA->out, KA->in[I_FFNN] + (size_t)lc * DM, (bf16*)(KA->ws + WS_H), nullptr, KA->in[I_WROUTER] + (size_t)lp * DM * NE, NE, nullptr, (float*)(KA->ws + WS_COMB));
            if (BOTH(pb + 11)) GRID_BAR();
        }
        for (int e = 0; e < NE; ++e) {
            if (IN(pb + 12 + 2 * e)) {
                pg8::EpiSwiGLU E{(pg8::bf16_t*)WSP(WS_ACT), FFE};
                GEMM_PHASE(pg8::EpiSwiGLU, WSP(WS_H), WSP(WS_MGU + (size_t)(lp * NE + e) * SZ_MGU), 2 * FFE, DM, E);
                if (BOTH(pb + 12 + 2 * e)) GRID_BAR();
            }
            if (IN(pb + 13 + 2 * e)) {
                const kargs_t KA = kargs();
                pg8::EpiRes E{KA->out, KA->out, DM, (const float*)(KA->ws + WS_COMB) + e, NE};
                GEMM_PHASE(pg8::EpiRes, WSP(WS_ACT), WSP(WS_MDN + (size_t)(lp * NE + e) * SZ_MDN), DM, FFE, E);
                if (BOTH(pb + 13 + 2 * e)) GRID_BAR();
            }
        }
    }
    if (IN(NPHASES - 1)) { TID_DECL;
        const kargs_t KA = kargs();
        norm_phase<3>(lds, gw, NGW, lane, tid, KA->out, KA->in[I_FINN], nullptr, KA->out, nullptr, 0, nullptr, nullptr);
    }
#undef IN
#undef BOTH
}

extern "C" void kernel_launch(void* const* d_in, const int* in_sizes, int n_in, void* d_out, int out_size, void* d_ws, size_t ws_size, hipStream_t stream) {
    static int grid = 0;
    if (grid == 0) {
        if (n_in != 17 || in_sizes[0] != M * DM || out_size != M * DM || ws_size < WS_END) { fprintf(stderr, "kernel_launch: shape/workspace mismatch: n_in %d in0 %d out %d ws %zu (need %zu)\n", n_in, n_in > 0 ? in_sizes[0] : -1, out_size, ws_size, (size_t)WS_END); grid = -1; return; }
        int dev = 0, cus = 0, per_cu = 0;
        if (hipGetDevice(&dev) != hipSuccess || hipDeviceGetAttribute(&cus, hipDeviceAttributeMultiprocessorCount, dev) != hipSuccess) { grid = -1; return; }
        if (hipFuncSetAttribute((const void*)mega_fwd, hipFuncAttributeMaxDynamicSharedMemorySize, LDS_BYTES) != hipSuccess) { fprintf(stderr, "kernel_launch: hipFuncSetAttribute failed\n"); grid = -1; return; }
        if (hipOccupancyMaxActiveBlocksPerMultiprocessor(&per_cu, (const void*)mega_fwd, NWAVES * 64, LDS_BYTES) != hipSuccess || per_cu < 1)
            fprintf(stderr, "kernel_launch: note: occupancy query reports %d workgroups per CU\n", per_cu);
        (void)hipGetLastError();
        grid = cus;
    }
    if (grid < 0) return;
    if (hipMemsetAsync((char*)d_ws + WS_CTL, 0, CTL_ZERO_BYTES, stream) != hipSuccess) { fprintf(stderr, "kernel_launch: memset failed\n"); return; }
    Args a{};
    for (int i = 0; i < 17; ++i) a.in[i] = (const float*)d_in[i];
    a.out = (float*)d_out; a.ws = (unsigned char*)d_ws;
    if (ONE_LAUNCH) {
        a.ph_lo = 0; a.ph_hi = NPHASES; a.li = 0;
        hipLaunchKernelGGL(mega_fwd, dim3(grid), dim3(NWAVES * 64), LDS_BYTES, stream, a);
    } else {
        for (int li = 0; li < NPHASES; ++li) { a.ph_lo = li; a.ph_hi = li + 1; a.li = li; hipLaunchKernelGGL(mega_fwd, dim3(grid), dim3(NWAVES * 64), LDS_BYTES, stream, a); }
    }
    const hipError_t le = hipPeekAtLastError();
    if (le != hipSuccess) fprintf(stderr, "kernel_launch: launch failed: %s\n", hipGetErrorName(le));
}
```

```cpp
#include <hip/hip_runtime.h>
#include <cstdio>
#include <cstdint>
#define MK_ONE_LAUNCH 1
#define SB_EARLY_EXIT true
#define FOX_EARLY_EXIT true
#define I8_AIN_MASK 3
#define I8_CIN_MASK 3
#define I8_GU_MASK 3
#define I8_MGU_MASK 3
#define FFN_GU8_MASK 0
#define FFN_DN8_MASK 2
__device__ __forceinline__ float lx(float v, int o, int lane) { return __uint_as_float((unsigned)__builtin_amdgcn_ds_bpermute((lane ^ o) << 2, (int)__float_as_uint(v))); }
__device__ __forceinline__ int lane_id_asm() { int l; asm volatile("v_mbcnt_lo_u32_b32 %0, -1, 0\n\tv_mbcnt_hi_u32_b32 %0, -1, %0" : "=v"(l)); return l; }
namespace pg8 {
#define PG8_LAS __attribute__((address_space(3)))
typedef unsigned short bf16_t;
typedef short bf16x8 __attribute__((ext_vector_type(8)));
typedef float f32x4 __attribute__((ext_vector_type(4)));
typedef int v8i_t __attribute__((ext_vector_type(8)));
typedef int v4i_t __attribute__((ext_vector_type(4)));
typedef short bf16x16_t __attribute__((ext_vector_type(16)));
template <bool F8> struct FragT { typedef bf16x8 A[4][2]; typedef bf16x8 B[2][2]; };
template <> struct FragT<true> { typedef v8i_t A[4]; typedef v8i_t B[2]; };
constexpr int FP8_SCALE_W = 0x79797979, FP8_SCALE_X = 0x7F7F7F7F;
typedef unsigned u32x4 __attribute__((ext_vector_type(4)));
constexpr int BM = 256, BK = 64, HALF = 128, HTB = HALF * BK * 2  , STAGE_BYTES = 8 * HTB, NXCD = 8, WGM = 4;

__host__ __device__ __forceinline__ int lds_byte(int r, int c) { const int st = (r >> 4) * 2 + (c >> 5), rr = r & 15, cc = c & 31, ob = rr * 64 + cc * 2; return st * 1024 + (ob ^ (((ob >> 9) & 1) << 5)); }
__host__ __device__ __forceinline__ void stage_rc(int b, int& R, int& C) { const int st = b / 1024, sb = b % 1024, swz = sb ^ (((sb >> 9) & 1) << 5); R = (st >> 1) * 16 + swz / 64; C = (st & 1) * 32 + (swz % 64) / 2; }
__host__ __device__ __forceinline__ int perm32(int rho) { const int n = rho >> 4, i = rho & 15; return 8 * (i >> 2) + 4 * n + (i & 3); }

struct Unit { int pm, pn; };
struct Gemm { const bf16_t* A; const bf16_t* Bt; int M, N, K; int sx8 = FP8_SCALE_X; };

struct StaticOrder {
    int nM, nN, nwg, G, c;
    __host__ __device__ void init(int M, int N, int G_, int c_) { nM = M / BM; nN = N / BM; nwg = nM * nN; G = G_; c = c_; }
    __host__ __device__ __forceinline__ bool next(int i, Unit& u) const {
        const long L = (long)i * G + c; if (L >= nwg) return false;
        int wgid = (int)L; { const int q = nwg / NXCD, r = nwg % NXCD, xcd = wgid % NXCD, off = wgid / NXCD; wgid = (xcd < r ? xcd * (q + 1) : r * (q + 1) + (xcd - r) * q) + off; }
        const int nig = WGM * nN, gid = wgid / nig, fm = gid * WGM, gsz = (nM - fm) < WGM ? (nM - fm) : WGM;
        u.pm = fm + ((wgid % nig) % gsz); u.pn = (wgid % nig) / gsz; return true;
    }
    static constexpr bool GATHER = false;
    __device__ __forceinline__ const char* bbase(const Unit&, const Gemm& g) const { return (const char*)g.Bt; }
    __device__ __forceinline__ int arow(const Unit&, int) const { return 0; }
    __device__ __forceinline__ void a_ready(const Unit&) const {}
    __device__ __forceinline__ void done(const Unit&) const {}
};
template <bool GATHER_> struct MoeOrder {
    static constexpr bool GATHER = GATHER_;
    int nM, nN, nwg, G, c; size_t bstride; const int* list; const PG8_LAS int* tab;
    __device__ void init(int P, int N, int G_, int c_, size_t bstride_, const int* list_, const PG8_LAS int* tab_) { nM = P; nN = N / BM; nwg = nM * nN; G = G_; c = c_; bstride = bstride_; list = list_; tab = tab_; }
    __device__ __forceinline__ bool next(int i, Unit& u) const {
        const long L = (long)i * G + c; if (L >= nwg) return false;
        int wgid = (int)L; { const int q = nwg / NXCD, r = nwg % NXCD, xcd = wgid % NXCD, off = wgid / NXCD; wgid = (xcd < r ? xcd * (q + 1) : r * (q + 1) + (xcd - r) * q) + off; }
        const int nig = WGM * nN, gid = wgid / nig, fm = gid * WGM, gsz = (nM - fm) < WGM ? (nM - fm) : WGM;
        u.pm = fm + ((wgid % nig) % gsz); u.pn = (wgid % nig) / gsz; return true;
    }
    __device__ __forceinline__ const char* bbase(const Unit& u, const Gemm& g) const { const int e = __builtin_amdgcn_readfirstlane(tab[8 + u.pm]); return (const char*)g.Bt + (size_t)e * bstride; }
    __device__ __forceinline__ int arow(const Unit& u, int r) const { const int e = tab[8 + u.pm], pos = tab[160 + u.pm] + r; return pos < tab[e] ? (list[e * 16384 + pos] >> 1) : 0; }
    __device__ __forceinline__ void a_ready(const Unit&) const {}
    __device__ __forceinline__ void done(const Unit&) const {}
};

__device__ __forceinline__ unsigned cvt_pk_bf16(float lo, float hi) { unsigned r; asm volatile("v_cvt_pk_bf16_f32 %0, %1, %2" : "=v"(r) : "v"(lo), "v"(hi)); return r; }
typedef float f32x2 __attribute__((ext_vector_type(2)));
typedef unsigned u32x2 __attribute__((ext_vector_type(2)));
template <bool I8> __device__ __forceinline__ f32x4 deq4(const f32x4 v, float s) {
    if (!I8) return v;
    f32x4 r; r[0] = (float)__float_as_int(v[0]) * s; r[1] = (float)__float_as_int(v[1]) * s; r[2] = (float)__float_as_int(v[2]) * s; r[3] = (float)__float_as_int(v[3]) * s; return r;
}
template <bool I8> __device__ __forceinline__ f32x4 deq4c(const f32x4 v, float s, const f32x4 c) {
    if (!I8) return v;
    f32x4 r; r[0] = (float)__float_as_int(v[0]) * s * c[0]; r[1] = (float)__float_as_int(v[1]) * s * c[1]; r[2] = (float)__float_as_int(v[2]) * s * c[2]; r[3] = (float)__float_as_int(v[3]) * s * c[3]; return r;
}
template <bool I8 = false>
struct EpiPlainBf16T {
    static constexpr bool PERM = true, AFTER_DRAIN = false;
    bf16_t* O; int ldc; const float* sx; const float* wsc;
    __device__ __forceinline__ void operator()(const f32x4 (&acc)[2][2][4][2], const Unit& u, int wr, int wc, int fr, int fq) const {
        const int row0 = u.pm * BM + wr * 64 + fr, col0 = u.pn * BM + wc * 32 + 8 * fq;
        f32x4 cs[2][2];
        if (I8) { cs[0][0] = *(const f32x4*)(wsc + col0); cs[0][1] = *(const f32x4*)(wsc + col0 + 4); cs[1][0] = *(const f32x4*)(wsc + col0 + HALF); cs[1][1] = *(const f32x4*)(wsc + col0 + HALF + 4); }
        float rs8[2][4];
#pragma unroll
        for (int ai = 0; ai < 2; ++ai)
#pragma unroll
            for (int m = 0; m < 4; ++m) rs8[ai][m] = I8 ? sx[row0 + ai * HALF + m * 16] : 1.0f;
#pragma unroll
        for (int ai = 0; ai < 2; ++ai)
#pragma unroll
            for (int m = 0; m < 4; ++m) { bf16_t* rowp = O + (size_t)(row0 + ai * HALF + m * 16) * ldc + col0;
                const float rsc = rs8[ai][m];
#pragma unroll
                for (int bj = 0; bj < 2; ++bj) { const f32x4 v0 = deq4c<I8>(acc[ai][bj][m][0], rsc, cs[bj][0]), v1 = deq4c<I8>(acc[ai][bj][m][1], rsc, cs[bj][1]);
                    u32x4 w; w.x = cvt_pk_bf16(v0[0], v0[1]); w.y = cvt_pk_bf16(v0[2], v0[3]); w.z = cvt_pk_bf16(v1[0], v1[1]); w.w = cvt_pk_bf16(v1[2], v1[3]);
                    *(u32x4*)(rowp + bj * HALF) = w; } }
    }
};
typedef EpiPlainBf16T<false> EpiPlainBf16;
template <bool I8 = false>
struct EpiConvInT {
    static constexpr bool PERM = true, AFTER_DRAIN = false;
    bf16_t* O; const float* sx; const float* wsc;
    __device__ __forceinline__ void operator()(const f32x4 (&acc)[2][2][4][2], const Unit& u, int wr, int wc, int fr, int fq) const {
        const int row0 = u.pm * BM + wr * 64 + fr, bc0 = u.pn * BM + wc * 32 + 8 * fq;
        f32x4 cs[2][2];
        if (I8) { cs[0][0] = *(const f32x4*)(wsc + bc0); cs[0][1] = *(const f32x4*)(wsc + bc0 + 4); cs[1][0] = *(const f32x4*)(wsc + bc0 + HALF); cs[1][1] = *(const f32x4*)(wsc + bc0 + HALF + 4); }
        float rs8[2][4];
#pragma unroll
        for (int ai = 0; ai < 2; ++ai)
#pragma unroll
            for (int m = 0; m < 4; ++m) rs8[ai][m] = I8 ? sx[row0 + ai * HALF + m * 16] : 1.0f;
        if (u.pn < 8) {
#pragma unroll
            for (int ai = 0; ai < 2; ++ai)
#pragma unroll
                for (int m = 0; m < 4; ++m) { bf16_t* rowp = O + (size_t)(row0 + ai * HALF + m * 16) * 4096 + bc0; const float rsc = rs8[ai][m];
#pragma unroll
                    for (int bj = 0; bj < 2; ++bj) { const f32x4 v0 = deq4c<I8>(acc[ai][bj][m][0], rsc, cs[bj][0]), v1 = deq4c<I8>(acc[ai][bj][m][1], rsc, cs[bj][1]);
                        u32x4 w; w.x = cvt_pk_bf16(v0[0], v0[1]); w.y = cvt_pk_bf16(v0[2], v0[3]); w.z = cvt_pk_bf16(v1[0], v1[1]); w.w = cvt_pk_bf16(v1[2], v1[3]);
                        *(u32x4*)(rowp + bj * HALF) = w; } }
        } else {
            const int col0 = 2048 + (u.pn - 8) * HALF + wc * 32 + 8 * fq;
#pragma unroll
            for (int ai = 0; ai < 2; ++ai)
#pragma unroll
                for (int m = 0; m < 4; ++m) { bf16_t* rowp = O + (size_t)(row0 + ai * HALF + m * 16) * 4096 + col0; const float rsc = rs8[ai][m];
                    const f32x4 g0 = deq4c<I8>(acc[ai][0][m][0], rsc, cs[0][0]), g1 = deq4c<I8>(acc[ai][0][m][1], rsc, cs[0][1]), u0 = deq4c<I8>(acc[ai][1][m][0], rsc, cs[1][0]), u1 = deq4c<I8>(acc[ai][1][m][1], rsc, cs[1][1]);
                    u32x4 w; w.x = cvt_pk_bf16(g0[0] * u0[0], g0[1] * u0[1]); w.y = cvt_pk_bf16(g0[2] * u0[2], g0[3] * u0[3]); w.z = cvt_pk_bf16(g1[0] * u1[0], g1[1] * u1[1]); w.w = cvt_pk_bf16(g1[2] * u1[2], g1[3] * u1[3]);
                    *(u32x4*)rowp = w; }
        }
    }
};
template <bool I8> __device__ __forceinline__ f32x4 swiglu4(const f32x4 ag, const f32x4 au, const f32x4 cg, const f32x4 cu, float rs) {
    f32x4 o;
#pragma unroll
    for (int h = 0; h < 2; ++h) {
        f32x2 g, ub;
        if (I8) { const f32x2 ig = {(float)__float_as_int(ag[2 * h]), (float)__float_as_int(ag[2 * h + 1])}, iu = {(float)__float_as_int(au[2 * h]), (float)__float_as_int(au[2 * h + 1])};
            const f32x2 cg2 = {cg[2 * h], cg[2 * h + 1]}, cu2 = {cu[2 * h], cu[2 * h + 1]}, rs2 = {rs, rs};
            g = (ig * cg2) * rs2; ub = (iu * cu2) * rs2; }
        else { g = (f32x2){ag[2 * h], ag[2 * h + 1]}; ub = (f32x2){au[2 * h], au[2 * h + 1]}; }
        const f32x2 mm = g * (f32x2){-1.4426950408889634f, -1.4426950408889634f};
        const f32x2 d = (f32x2){__builtin_amdgcn_exp2f(mm[0]), __builtin_amdgcn_exp2f(mm[1])} + (f32x2){1.0f, 1.0f};
        const f32x2 r = {__builtin_amdgcn_rcpf(d[0]), __builtin_amdgcn_rcpf(d[1])};
        const f32x2 res = (g * ub) * r;
        o[2 * h] = res[0]; o[2 * h + 1] = res[1];
    }
    return o;
}
__device__ __forceinline__ float silu_mul(float g, float u) { return g * __builtin_amdgcn_rcpf(1.0f + __builtin_amdgcn_exp2f(-1.4426950408889634f * g)) * u; }
template <int I8 = 0>
struct EpiSwiGLUT {
    static constexpr bool PERM = true, AFTER_DRAIN = false;
    bf16_t* O; int ldc; const float* sx; const float* wsc; const PG8_LAS int* tab;
    __device__ __forceinline__ void operator()(const f32x4 (&acc)[2][2][4][2], const Unit& u, int wr, int wc, int fr, int fq) const {
        const int row0 = u.pm * BM + wr * 64 + fr, col0 = u.pn * HALF + wc * 32 + 8 * fq;
        f32x4 cs[2][2]; int me = 0, mp = 0, mc = 0;
        if (I8 == 2) { me = tab[8 + u.pm]; mp = tab[160 + u.pm] + wr * 64 + fr; mc = tab[me]; }
        if (I8) { const float* wc_ = wsc + (I8 == 2 ? me * (2 * 2816) : 0) + u.pn * BM + wc * 32 + 8 * fq;
            cs[0][0] = *(const f32x4*)(wc_); cs[0][1] = *(const f32x4*)(wc_ + 4); cs[1][0] = *(const f32x4*)(wc_ + HALF); cs[1][1] = *(const f32x4*)(wc_ + HALF + 4); }
        float rs8[2][4];
#pragma unroll
        for (int ai = 0; ai < 2; ++ai)
#pragma unroll
            for (int m = 0; m < 4; ++m) { float r_ = 1.0f;
                if (I8 == 1) r_ = sx[row0 + ai * HALF + m * 16];
                if (I8 == 2) { const int pos = mp + ai * HALF + m * 16; r_ = pos < mc ? sx[me * 16384 + pos] : 0.f; }
                rs8[ai][m] = r_; }
#pragma unroll
        for (int ai = 0; ai < 2; ++ai)
#pragma unroll
            for (int m = 0; m < 4; ++m) { bf16_t* rowp = O + (size_t)(row0 + ai * HALF + m * 16) * ldc + col0;
                const float rsc = rs8[ai][m];
                const f32x4 s0 = swiglu4<(I8 != 0)>(acc[ai][0][m][0], acc[ai][1][m][0], cs[0][0], cs[1][0], rsc), s1 = swiglu4<(I8 != 0)>(acc[ai][0][m][1], acc[ai][1][m][1], cs[0][1], cs[1][1], rsc);
                u32x4 w; w.x = cvt_pk_bf16(s0[0], s0[1]); w.y = cvt_pk_bf16(s0[2], s0[3]); w.z = cvt_pk_bf16(s1[0], s1[1]); w.w = cvt_pk_bf16(s1[2], s1[3]);
                *(u32x4*)rowp = w; }
    }
};
typedef EpiSwiGLUT<0> EpiSwiGLU;
__device__ __forceinline__ unsigned pack_fp8x4(float a, float b, float c, float d) { int p = 0; p = __builtin_amdgcn_cvt_pk_fp8_f32(a, b, p, false); p = __builtin_amdgcn_cvt_pk_fp8_f32(c, d, p, true); return (unsigned)p; }
template <int I8 = 0>
struct EpiSwiGLU8T {
    static constexpr bool PERM = true, AFTER_DRAIN = false;
    unsigned char* O; int ldc; const float* sx; const float* wsc; const PG8_LAS int* tab;
    __device__ __forceinline__ void operator()(const f32x4 (&acc)[2][2][4][2], const Unit& u, int wr, int wc, int fr, int fq) const {
        const int row0 = u.pm * BM + wr * 64 + fr, col0 = u.pn * HALF + wc * 32 + 8 * fq;
        f32x4 cs[2][2]; int me = 0, mp = 0, mc = 0;
        if (I8 == 2) { me = tab[8 + u.pm]; mp = tab[160 + u.pm] + wr * 64 + fr; mc = tab[me]; }
        if (I8) { const float* wc_ = wsc + (I8 == 2 ? me * (2 * 2816) : 0) + u.pn * BM + wc * 32 + 8 * fq;
            cs[0][0] = *(const f32x4*)(wc_); cs[0][1] = *(const f32x4*)(wc_ + 4); cs[1][0] = *(const f32x4*)(wc_ + HALF); cs[1][1] = *(const f32x4*)(wc_ + HALF + 4); }
        float rs8[2][4];
#pragma unroll
        for (int ai = 0; ai < 2; ++ai)
#pragma unroll
            for (int m = 0; m < 4; ++m) { float r_ = 1.0f;
                if (I8 == 1) r_ = sx[row0 + ai * HALF + m * 16];
                if (I8 == 2) { const int pos = mp + ai * HALF + m * 16; r_ = pos < mc ? sx[me * 16384 + pos] : 0.f; }
                rs8[ai][m] = r_; }
#pragma unroll
        for (int ai = 0; ai < 2; ++ai)
#pragma unroll
            for (int m = 0; m < 4; ++m) { unsigned char* rowp = O + (size_t)(row0 + ai * HALF + m * 16) * ldc + col0;
                const float rsc = rs8[ai][m];
                const f32x4 s0 = swiglu4<(I8 != 0)>(acc[ai][0][m][0], acc[ai][1][m][0], cs[0][0], cs[1][0], rsc), s1 = swiglu4<(I8 != 0)>(acc[ai][0][m][1], acc[ai][1][m][1], cs[0][1], cs[1][1], rsc);
                u32x2 w; w.x = pack_fp8x4(s0[0], s0[1], s0[2], s0[3]); w.y = pack_fp8x4(s1[0], s1[1], s1[2], s1[3]);
                *(u32x2*)rowp = w; }
    }
};
typedef EpiSwiGLU8T<0> EpiSwiGLU8;
struct EpiRes {
    static constexpr bool PERM = false, AFTER_DRAIN = false;
    const float* base; float* out; int ldc; const float* rs; int rs_stride;
    __device__ __forceinline__ void operator()(const f32x4 (&acc)[2][2][4][2], const Unit& u, int wr, int wc, int fr, int fq) const {
        const int row0 = u.pm * BM + wr * 64 + fr, col0 = u.pn * BM + wc * 32 + 4 * fq;
        f32x4 b[2][2][2][2];
#define EPIRES_LD(buf, ap_) do { const int ai_ = (ap_) >> 1, mp_ = (ap_) & 1; _Pragma("unroll") for (int mm = 0; mm < 2; ++mm) { const size_t off = (size_t)(row0 + ai_ * HALF + (2 * mp_ + mm) * 16) * ldc + col0; \
            _Pragma("unroll") for (int bj = 0; bj < 2; ++bj) _Pragma("unroll") for (int n = 0; n < 2; ++n) b[buf][mm][bj][n] = *(const f32x4*)(base + off + bj * HALF + n * 16); } } while (0)
#define EPIRES_ST(buf, ap_) do { const int ai_ = (ap_) >> 1, mp_ = (ap_) & 1; _Pragma("unroll") for (int mm = 0; mm < 2; ++mm) { const int m = 2 * mp_ + mm; const size_t off = (size_t)(row0 + ai_ * HALF + m * 16) * ldc + col0; \
            _Pragma("unroll") for (int bj = 0; bj < 2; ++bj) _Pragma("unroll") for (int n = 0; n < 2; ++n) *(f32x4*)(out + off + bj * HALF + n * 16) = b[buf][mm][bj][n] + acc[ai_][bj][m][n]; } } while (0)
        EPIRES_LD(0, 0); asm volatile("" ::: "memory");
        EPIRES_LD(1, 1); asm volatile("" ::: "memory"); EPIRES_ST(0, 0); asm volatile("" ::: "memory");
        EPIRES_LD(0, 2); asm volatile("" ::: "memory"); EPIRES_ST(1, 1); asm volatile("" ::: "memory");
        EPIRES_LD(1, 3); asm volatile("" ::: "memory"); EPIRES_ST(0, 2); asm volatile("" ::: "memory");
        EPIRES_ST(1, 3); asm volatile("" ::: "memory");
#undef EPIRES_LD
#undef EPIRES_ST
    }
};
template <bool I8 = false>
struct EpiQKVT {
    static constexpr bool PERM = true, AFTER_DRAIN = false;
    bf16_t* O; int ldc; unsigned* kmax; const float* sx; const float* wsc;
    __device__ __forceinline__ void operator()(const f32x4 (&acc)[2][2][4][2], const Unit& u, int wr, int wc, int fr, int fq) const {
        const int row0 = u.pm * BM + wr * 64 + fr, col0 = u.pn * BM + wc * 32 + 8 * fq;
        float mx0 = 0.f, mx1 = 0.f;
        f32x4 cs[2][2];
        if (I8) { cs[0][0] = *(const f32x4*)(wsc + col0); cs[0][1] = *(const f32x4*)(wsc + col0 + 4); cs[1][0] = *(const f32x4*)(wsc + col0 + HALF); cs[1][1] = *(const f32x4*)(wsc + col0 + HALF + 4); }
        float rs8[2][4];
#pragma unroll
        for (int ai = 0; ai < 2; ++ai)
#pragma unroll
            for (int m = 0; m < 4; ++m) rs8[ai][m] = I8 ? sx[row0 + ai * HALF + m * 16] : 1.0f;
#pragma unroll
        for (int ai = 0; ai < 2; ++ai)
#pragma unroll
            for (int m = 0; m < 4; ++m) { bf16_t* rowp = O + (size_t)(row0 + ai * HALF + m * 16) * ldc + col0;
                const float rsc = rs8[ai][m];
#pragma unroll
                for (int bj = 0; bj < 2; ++bj) { const f32x4 v0 = deq4c<I8>(acc[ai][bj][m][0], rsc, cs[bj][0]), v1 = deq4c<I8>(acc[ai][bj][m][1], rsc, cs[bj][1]);
                    u32x4 w; w.x = cvt_pk_bf16(v0[0], v0[1]); w.y = cvt_pk_bf16(v0[2], v0[3]); w.z = cvt_pk_bf16(v1[0], v1[1]); w.w = cvt_pk_bf16(v1[2], v1[3]);
                    *(u32x4*)(rowp + bj * HALF) = w;
                    const float s = ((v0[0] * v0[0] + v0[1] * v0[1]) + (v0[2] * v0[2] + v0[3] * v0[3])) + ((v1[0] * v1[0] + v1[1] * v1[1]) + (v1[2] * v1[2] + v1[3] * v1[3]));
                    float t = s; t += lx(t, 16, fr + 16 * fq); t += lx(t, 32, fr + 16 * fq);
                    if (bj == 0) mx0 = fmaxf(mx0, t); else mx1 = fmaxf(mx1, t); } }
        if (u.pn >= 4 && u.pn < 8) {
#pragma unroll
            for (int o = 1; o < 16; o <<= 1) { mx0 = fmaxf(mx0, lx(mx0, o, fr + 16 * fq)); mx1 = fmaxf(mx1, lx(mx1, o, fr + 16 * fq)); }
            if (fr == 0 && fq == 0) { const int b = u.pm >> 4, h0 = (u.pn - 4) * 2;
                atomicMax(kmax + ((b * 8 + h0) * 4 + wc), __float_as_uint(mx0)); atomicMax(kmax + ((b * 8 + h0 + 1) * 4 + wc), __float_as_uint(mx1)); }
        }
    }
    __device__ __forceinline__ void init(f32x4 (&acc)[2][2][4][2], const Unit&, int, int, int, int) const {
#pragma unroll
        for (int a = 0; a < 2; ++a)
#pragma unroll
            for (int b = 0; b < 2; ++b)
#pragma unroll
                for (int m = 0; m < 4; ++m)
#pragma unroll
                    for (int n = 0; n < 2; ++n) acc[a][b][m][n] = (f32x4){0.f, 0.f, 0.f, 0.f};
    }
};
typedef EpiQKVT<false> EpiQKV;
struct EpiMoeDown {
    static constexpr bool PERM = true, AFTER_DRAIN = false;
    bf16_t* Y; int ldc; const int* list; const float* gate; const PG8_LAS int* tab;
    __device__ __forceinline__ void operator()(const f32x4 (&acc)[2][2][4][2], const Unit& u, int wr, int wc, int fr, int fq) const {
        const int e = tab[8 + u.pm], pbase = tab[160 + u.pm], cnt = tab[e];
        const int col0 = u.pn * BM + wc * 32 + 8 * fq;
        int sl8[2][4]; float gt8[2][4];
#pragma unroll
        for (int ai = 0; ai < 2; ++ai)
#pragma unroll
            for (int m = 0; m < 4; ++m) { const int pos = pbase + ai * HALF + wr * 64 + m * 16 + fr, pc = pos < cnt ? pos : cnt - 1; sl8[ai][m] = list[e * 16384 + pc]; gt8[ai][m] = gate[e * 16384 + pc]; }
#pragma unroll
        for (int ai = 0; ai < 2; ++ai)
#pragma unroll
            for (int m = 0; m < 4; ++m) { const int pos = pbase + ai * HALF + wr * 64 + m * 16 + fr;
                if (pos < cnt) { const int slot = sl8[ai][m]; const float gt = gt8[ai][m]; bf16_t* rowp = Y + (size_t)slot * ldc + col0;
#pragma unroll
                    for (int bj = 0; bj < 2; ++bj) { const f32x4 v0 = acc[ai][bj][m][0] * gt, v1 = acc[ai][bj][m][1] * gt;
                        u32x4 w; w.x = cvt_pk_bf16(v0[0], v0[1]); w.y = cvt_pk_bf16(v0[2], v0[3]); w.z = cvt_pk_bf16(v1[0], v1[1]); w.w = cvt_pk_bf16(v1[2], v1[3]);
                        *(u32x4*)(rowp + bj * HALF) = w; } } }
    }
};
template <class Epi, class Sched, bool ALIGN_EPI = false, bool SP2 = false, int LOWP = 0>
__device__ __forceinline__ void gemm_phase(PG8_LAS unsigned char* lds, const Gemm g, const Sched& S, const Epi& E, const int wv) {
    int tid_ = wv * 64 + lane_id_asm(); asm volatile("" : "+v"(tid_));
    const int tid = tid_, wid = __builtin_amdgcn_readfirstlane(tid >> 6), lane = tid & 63, wr = wid >> 2, wc = wid & 3, fr = lane & 15, fq = lane >> 4;
    const int K = g.K, nt = K / BK;
    constexpr bool FP8 = (LOWP == 1), I8 = (LOWP == 2);
    constexpr bool GATH = Sched::GATHER;
    unsigned voffB[2], vA0[2], vA1[2], nvA0[2], nvA1[2]; int sR[2], sC[2];
    const size_t kstep = (size_t)(BK * 2);
    const size_t hstep = (size_t)HALF * K * 2;
    const size_t tstep = 2 * hstep;
#pragma unroll
    for (int i = 0; i < 2; ++i) { int R, C; stage_rc(tid * 16 + i * 8192, R, C); const int Rb = Epi::PERM ? ((R & ~31) + perm32(R & 31)) : R; sR[i] = R; sC[i] = C;
        vA0[i] = (unsigned)(R * K + C) * 2u; vA1[i] = vA0[i] + (unsigned)hstep; nvA0[i] = vA0[i]; nvA1[i] = vA1[i]; voffB[i] = (unsigned)(Rb * K + C) * 2u; }
#define PG8_GROWS(U, d0, d1) do { _Pragma("unroll") for (int _i = 0; _i < 2; ++_i) { d0[_i] = (unsigned)(S.arow(U, sR[_i]) * K + sC[_i]) * 2u; d1[_i] = (unsigned)(S.arow(U, HALF + sR[_i]) * K + sC[_i]) * 2u; } } while (0)
    const unsigned ldsw = (unsigned)wid * 1024u;
    const int aoff = FP8 ? lds_byte(wr * 64 + fr, 16 * (fq & 1)) + (fq >> 1) * 1024 : lds_byte(wr * 64 + fr, fq * 8);
    const int boff = FP8 ? lds_byte(wc * 32 + fr, 16 * (fq & 1)) + (fq >> 1) * 1024 : lds_byte(wc * 32 + fr, fq * 8);
#define PG8_SA(b, h) (((b) * 2 + (h)) * HTB)
#define PG8_SB(b, h) ((4 + (b) * 2 + (h)) * HTB)
#define PG8_STAGE(bufoff, gbase, voff) do { _Pragma("unroll") for (int _i = 0; _i < 2; ++_i) \
        __builtin_amdgcn_global_load_lds((const unsigned*)((const char*)(gbase) + (voff)[_i]), (PG8_LAS unsigned*)(lds + (bufoff) + ldsw + _i * 8192), 16, 0, 0); } while (0)
#define PG8_CAT(x0, x1) (__builtin_bit_cast(v8i_t, (bf16x16_t)__builtin_shufflevector((x0), (x1), 0, 1, 2, 3, 4, 5, 6, 7, 8, 9, 10, 11, 12, 13, 14, 15)))
#define PG8_LDA(dst, b, h) do { if constexpr (FP8) { _Pragma("unroll") for (int m = 0; m < 4; ++m) { const PG8_LAS bf16x8* p_ = (const PG8_LAS bf16x8*)(lds + PG8_SA(b, h) + aoff + m * 2048); dst[m] = PG8_CAT(p_[0], p_[1]); } } \
        else { _Pragma("unroll") for (int m = 0; m < 4; ++m) _Pragma("unroll") for (int k = 0; k < 2; ++k) dst[m][k] = *(const PG8_LAS bf16x8*)(lds + PG8_SA(b, h) + aoff + m * 2048 + k * 1024); } } while (0)
#define PG8_LDB(dst, b, h) do { if constexpr (FP8) { _Pragma("unroll") for (int n = 0; n < 2; ++n) { const PG8_LAS bf16x8* p_ = (const PG8_LAS bf16x8*)(lds + PG8_SB(b, h) + boff + n * 2048); dst[n] = PG8_CAT(p_[0], p_[1]); } } \
        else { _Pragma("unroll") for (int n = 0; n < 2; ++n) _Pragma("unroll") for (int k = 0; k < 2; ++k) dst[n][k] = *(const PG8_LAS bf16x8*)(lds + PG8_SB(b, h) + boff + n * 2048 + k * 1024); } } while (0)
#define PG8_MMA(ai, bj, At, Bt) do { __builtin_amdgcn_s_setprio(1); if constexpr (FP8) { _Pragma("unroll") for (int m = 0; m < 4; ++m) _Pragma("unroll") for (int n = 0; n < 2; ++n) \
        asm volatile("v_mfma_scale_f32_16x16x128_f8f6f4 %0, %1, %2, %0, %3, %4 op_sel_hi:[0,0,0]" : "+v"(acc[ai][bj][m][n]) : "v"(Bt[n]), "v"(At[m]), "v"(f8sw), "v"(f8sx));     } else { \
        _Pragma("unroll") for (int m = 0; m < 4; ++m) _Pragma("unroll") for (int n = 0; n < 2; ++n) _Pragma("unroll") for (int k = 0; k < 2; ++k) { \
        if constexpr (I8) acc[ai][bj][m][n] = __builtin_bit_cast(f32x4, __builtin_amdgcn_mfma_i32_16x16x64_i8(__builtin_bit_cast(v4i_t, Bt[n][k]), __builtin_bit_cast(v4i_t, At[m][k]), __builtin_bit_cast(v4i_t, acc[ai][bj][m][n]), 0, 0, 0)); \
        else acc[ai][bj][m][n] = __builtin_amdgcn_mfma_f32_16x16x32_bf16(Bt[n][k], At[m][k], acc[ai][bj][m][n], 0, 0, 0); } } __builtin_amdgcn_s_setprio(0); } while (0)
#define PG8_WAIT_V(n) asm volatile("s_waitcnt vmcnt(" #n ")" ::: "memory")
#define PG8_WAIT_L(n) asm volatile("s_waitcnt lgkmcnt(" #n ")" ::: "memory")
#define PG8_BAR __builtin_amdgcn_s_barrier()
#define PG8_SCHED __builtin_amdgcn_sched_barrier(0)
    Unit cur, nxt; int ui = 0;
    if (!S.next(0, cur)) return;
#ifdef PG8_SKEW
    { const int sk_ = ((int)blockIdx.x >> 3) & 3;
      for (int i_ = 0; i_ < sk_; ++i_) __builtin_amdgcn_s_sleep(PG8_SKEW); }
#endif
    f32x4 acc[2][2][4][2];
#pragma unroll
    for (int a = 0; a < 2; ++a)
#pragma unroll
        for (int b = 0; b < 2; ++b)
#pragma unroll
            for (int m = 0; m < 4; ++m)
#pragma unroll
                for (int n = 0; n < 2; ++n) acc[a][b][m][n] = (f32x4){0.f, 0.f, 0.f, 0.f};
    const int f8sw = FP8_SCALE_W, f8sx = g.sx8; (void)f8sw; (void)f8sx;
    typename FragT<FP8>::A At; typename FragT<FP8>::B B0, B1;
    const char* cA = GATH ? (const char*)g.A : (const char*)g.A + (size_t)cur.pm * tstep; const char* cB = S.bbase(cur, g) + (size_t)cur.pn * tstep;
    if constexpr (GATH) { PG8_GROWS(cur, vA0, vA1); }
    S.a_ready(cur);
    if constexpr (SP2) {
        PG8_STAGE(PG8_SB(0, 0), cB, voffB); PG8_STAGE(PG8_SB(0, 1), cB + hstep, voffB); PG8_STAGE(PG8_SA(0, 0), cA, vA0); PG8_STAGE(PG8_SA(0, 1), cA, vA1);
        if (wr == 1) PG8_BAR;
        PG8_WAIT_V(2); PG8_BAR;
        PG8_STAGE(PG8_SB(1, 0), cB + kstep, voffB); PG8_STAGE(PG8_SA(1, 0), cA + kstep, vA0); PG8_STAGE(PG8_SB(1, 1), cB + hstep + kstep, voffB);
        PG8_WAIT_V(6); PG8_BAR;
    } else {
        PG8_STAGE(PG8_SB(0, 0), cB, voffB); PG8_STAGE(PG8_SA(0, 0), cA, vA0); PG8_STAGE(PG8_SB(0, 1), cB + hstep, voffB); PG8_STAGE(PG8_SA(0, 1), cA, vA1);
        if (wr == 1) PG8_BAR;
        PG8_WAIT_V(4); PG8_BAR;
        PG8_STAGE(PG8_SB(1, 0), cB + kstep, voffB); PG8_STAGE(PG8_SA(1, 0), cA + kstep, vA0); PG8_STAGE(PG8_SB(1, 1), cB + hstep + kstep, voffB);
        PG8_WAIT_V(6); PG8_BAR;
    }
    for (;;) {
        const bool has_next = S.next(ui + 1, nxt);
        const char* nA = (has_next && !GATH) ? (const char*)g.A + (size_t)nxt.pm * tstep : cA; const char* nB = has_next ? S.bbase(nxt, g) + (size_t)nxt.pn * tstep : cB;
        if constexpr (GATH) { if (has_next) { PG8_GROWS(nxt, nvA0, nvA1); } else {
#pragma unroll
            for (int i = 0; i < 2; ++i) { nvA0[i] = vA0[i]; nvA1[i] = vA1[i]; } } }
        for (int t = 0; t < nt; t += 2) {
            const bool last = (t == nt - 2);
            const char* a1 = cA + (size_t)(t + 1) * kstep;
            const char* a2 = last ? nA : cA + (size_t)(t + 2) * kstep; const char* b2 = last ? nB : cB + (size_t)(t + 2) * kstep;
            const char* a3 = a2 + kstep; const char* b3 = b2 + kstep;
            if (last && has_next) S.a_ready(nxt);
            unsigned xA0[2], xA1[2];
#pragma unroll
            for (int i = 0; i < 2; ++i) { xA0[i] = (GATH && last) ? nvA0[i] : vA0[i]; xA1[i] = (GATH && last) ? nvA1[i] : vA1[i]; }
            if constexpr (SP2) {
            PG8_LDB(B0, 0, 0); PG8_LDB(B1, 0, 1); PG8_SCHED; PG8_LDA(At, 0, 0); PG8_STAGE(PG8_SA(1, 1), a1, vA1);
            PG8_WAIT_V(8); PG8_WAIT_L(0); PG8_BAR; PG8_MMA(0, 0, At, B0); PG8_MMA(0, 1, At, B1); PG8_BAR; PG8_SCHED;
            PG8_LDA(At, 0, 1); PG8_STAGE(PG8_SB(0, 0), b2, voffB); PG8_STAGE(PG8_SB(0, 1), b2 + hstep, voffB); PG8_STAGE(PG8_SA(0, 0), a2, xA0);
            PG8_WAIT_V(8); PG8_WAIT_L(0); PG8_BAR; PG8_MMA(1, 0, At, B0); PG8_MMA(1, 1, At, B1); PG8_BAR; PG8_SCHED;
            PG8_LDB(B0, 1, 0); PG8_LDB(B1, 1, 1); PG8_SCHED; PG8_LDA(At, 1, 0); PG8_STAGE(PG8_SA(0, 1), a2, xA1);
            PG8_WAIT_V(8); PG8_WAIT_L(0); PG8_BAR; PG8_MMA(0, 0, At, B0); PG8_MMA(0, 1, At, B1); PG8_BAR; PG8_SCHED;
            PG8_LDA(At, 1, 1); PG8_STAGE(PG8_SB(1, 0), b3, voffB); PG8_STAGE(PG8_SB(1, 1), b3 + hstep, voffB); PG8_STAGE(PG8_SA(1, 0), a3, xA0);
            PG8_WAIT_V(8); PG8_WAIT_L(0); PG8_BAR; PG8_MMA(1, 0, At, B0); PG8_MMA(1, 1, At, B1); PG8_BAR; PG8_SCHED;
            } else {
            PG8_LDB(B0, 0, 0); PG8_SCHED; PG8_LDA(At, 0, 0); PG8_STAGE(PG8_SA(1, 1), a1, vA1);
            PG8_WAIT_L(8); PG8_BAR; PG8_WAIT_L(0); PG8_MMA(0, 0, At, B0); PG8_BAR; PG8_SCHED;
            PG8_LDB(B1, 0, 1); PG8_STAGE(PG8_SB(0, 0), b2, voffB);
            PG8_BAR; PG8_WAIT_L(0); PG8_MMA(0, 1, At, B1); PG8_BAR;
            PG8_LDA(At, 0, 1); PG8_STAGE(PG8_SA(0, 0), a2, xA0);
            PG8_BAR; PG8_WAIT_L(0); PG8_MMA(1, 0, At, B0); PG8_BAR; PG8_SCHED;
            PG8_STAGE(PG8_SB(0, 1), b2 + hstep, voffB);
            PG8_WAIT_V(6); PG8_BAR; PG8_MMA(1, 1, At, B1); PG8_BAR;
            PG8_LDB(B0, 1, 0); PG8_SCHED; PG8_LDA(At, 1, 0); PG8_STAGE(PG8_SA(0, 1), a2, xA1);
            PG8_WAIT_L(8); PG8_BAR; PG8_WAIT_L(0); PG8_MMA(0, 0, At, B0); PG8_BAR; PG8_SCHED;
            PG8_LDB(B1, 1, 1); PG8_STAGE(PG8_SB(1, 0), b3, voffB);
            PG8_BAR; PG8_WAIT_L(0); PG8_MMA(0, 1, At, B1); PG8_BAR;
            PG8_LDA(At, 1, 1); PG8_STAGE(PG8_SA(1, 0), a3, xA0);
            PG8_BAR; PG8_WAIT_L(0); PG8_MMA(1, 0, At, B0); PG8_BAR; PG8_SCHED;
            PG8_STAGE(PG8_SB(1, 1), b3 + hstep, voffB);
            PG8_WAIT_V(6); PG8_BAR; PG8_MMA(1, 1, At, B1); PG8_BAR;
            }
        }
        if constexpr (FP8) asm volatile("s_nop 15\n\ts_nop 15\n\ts_nop 15" ::: "memory");
        if constexpr (ALIGN_EPI) { if (wr == 0) PG8_BAR; }
        if constexpr (!Epi::AFTER_DRAIN) { E(acc, cur, wr, wc, fr, fq); S.done(cur); }
        if (!has_next) break;
#pragma unroll
        for (int a = 0; a < 2; ++a)
#pragma unroll
            for (int b = 0; b < 2; ++b)
#pragma unroll
                for (int m = 0; m < 4; ++m)
#pragma unroll
                    for (int n = 0; n < 2; ++n) acc[a][b][m][n] = (f32x4){0.f, 0.f, 0.f, 0.f};
        cur = nxt; cA = nA; cB = nB; ++ui;
        if constexpr (GATH) {
#pragma unroll
            for (int i = 0; i < 2; ++i) { vA0[i] = nvA0[i]; vA1[i] = nvA1[i]; } }
        if constexpr (ALIGN_EPI) { if (wr == 1) PG8_BAR; }
    }
    PG8_WAIT_V(0);
    if constexpr (!ALIGN_EPI) { if (wr == 0) PG8_BAR; }
    PG8_BAR;
    if constexpr (Epi::AFTER_DRAIN) { E.fused(acc, cur, wr, wc, fr, fq, lds, wid, lane); S.done(cur); }
#undef PG8_SA
#undef PG8_GROWS
#undef PG8_SB
#undef PG8_STAGE
#undef PG8_LDA
#undef PG8_LDB
#undef PG8_MMA
#undef PG8_CAT
#undef PG8_WAIT_V
#undef PG8_WAIT_L
#undef PG8_BAR
#undef PG8_SCHED
}
}
#ifndef FFN_FP8_MASK
#define FFN_FP8_MASK 2
#endif
#ifndef MOE_FP8_MASK
#define MOE_FP8_MASK 3
#endif
#ifndef I8_AIN_MASK
#define I8_AIN_MASK 0
#endif
#ifndef I8_CIN_MASK
#define I8_CIN_MASK 0
#endif
#define I8_AIN_LP(lp_) (((I8_AIN_MASK) >> (lp_)) & 1)
#define I8_CIN_LP(lp_) (((I8_CIN_MASK) >> (lp_)) & 1)
#ifndef AOUT8_MASK
#define AOUT8_MASK 0
#endif
#ifndef COUT8_MASK
#define COUT8_MASK 0
#endif
#define AOUT8_LP(lp_) (((AOUT8_MASK) >> (lp_)) & 1)
#define COUT8_LP(lp_) (((COUT8_MASK) >> (lp_)) & 1)
#ifndef FOX_CUT
#define FOX_CUT -64.0f
#endif
#ifndef SB_CUT_LOG2
#define SB_CUT_LOG2 -64.0f
#endif
#ifndef ATT_XCDQ
#define ATT_XCDQ 1
#endif
#ifndef P0_NOBAR
#define P0_NOBAR 0
#endif
#ifndef ATT_DYN_SB
#define ATT_DYN_SB 2
#endif
#ifndef I8_MGU_MASK
#define I8_MGU_MASK 0
#endif
#define I8_MGU_LP(lp_) (((I8_MGU_MASK) >> (lp_)) & 1)
#ifndef I8_GU_MASK
#define I8_GU_MASK 0
#endif
#define I8_GU_LP(lp_) (((I8_GU_MASK) >> (lp_)) & 1)
#ifndef FFN_GU8_MASK
#define FFN_GU8_MASK FFN_FP8_MASK
#endif
#ifndef FFN_DN8_MASK
#define FFN_DN8_MASK FFN_FP8_MASK
#endif
#define FFN_GU8_LP(lp_) (((FFN_GU8_MASK) >> (lp_)) & 1)
#define FFN_DN8_LP(lp_) (((FFN_DN8_MASK) >> (lp_)) & 1)
#define MOE_FP8_LP(lp_) (((MOE_FP8_MASK) >> (lp_)) & 1)
#ifndef FOX_EARLY_EXIT
#define FOX_EARLY_EXIT false
#endif
#ifndef SB_EARLY_EXIT
#define SB_EARLY_EXIT false
#endif
#ifndef PG8_SP2
#define PG8_SP2 true
#endif
#ifndef PG8_ALIGN
#define PG8_ALIGN true
#endif
constexpr int NWAVES = 8;
constexpr int NBATCH = 4, SEQ = 4096, DM = 2048, M = NBATCH * SEQ;
constexpr int HD = 128, NHG = 8;
constexpr int NATT = 6144, ATT_SRC_LD = 6152;
constexpr int FF = 5632, NE = 8, FFE = 2816;
constexpr float RMS_EPS = 1e-6f;
constexpr float LOG2E = 1.4426950408889634f;
constexpr float QSCALE = 0.08838834764831845f * 1.4426950408889634f;

#ifndef MK_ONE_LAUNCH
#define MK_ONE_LAUNCH 1
#define SB_EARLY_EXIT true
#define FOX_EARLY_EXIT true
#define I8_AIN_MASK 3
#define I8_CIN_MASK 3
#define I8_GU_MASK 3
#define I8_MGU_MASK 3
#define FFN_GU8_MASK 0
#define FFN_DN8_MASK 2
#endif
constexpr int PH_PER_LP = 14;
constexpr int NPHASES = 1 + 2 * PH_PER_LP + 1;
constexpr bool ONE_LAUNCH = (MK_ONE_LAUNCH != 0);

constexpr int LDSCTL_OFF_FWD = 131072;
constexpr size_t MiB = 1u << 20;
constexpr size_t WS_CTL = 0, CTL_ZERO_BYTES = 1 * MiB;
constexpr size_t SZ_AIN = 24 * MiB, SZ_SQ = 8 * MiB, SZ_GU = 44 * MiB, SZ_DN = 22 * MiB, SZ_MGU = 22 * MiB, SZ_MDN = 11 * MiB;
constexpr size_t WS_AIN = 1 * MiB;
constexpr size_t WS_AOUT = WS_AIN + 2 * SZ_AIN;
constexpr size_t WS_CIN = WS_AOUT + 2 * SZ_SQ;
constexpr size_t WS_COUT = WS_CIN + 2 * SZ_AIN;
constexpr size_t WS_GU = WS_COUT + 2 * SZ_SQ;
constexpr size_t WS_DN = WS_GU + 2 * SZ_GU;
constexpr size_t WS_MGU = WS_DN + 2 * SZ_DN;
constexpr size_t WS_MDN = WS_MGU + 16 * SZ_MGU;
constexpr size_t WS_H = WS_MDN + 16 * SZ_MDN;
constexpr size_t WS_QKV = WS_H + 64 * MiB;
constexpr size_t WS_O = WS_QKV + 192 * MiB;
constexpr size_t WS_ACT = WS_O + 64 * MiB;
constexpr size_t WS_SMALL = WS_ACT + 192 * MiB;
constexpr size_t WS_LOGF = WS_SMALL;
constexpr size_t WS_C2 = WS_SMALL + 1 * MiB;
constexpr size_t WS_SX = WS_SMALL + 12 * MiB;
constexpr size_t WS_MSC = WS_SMALL + 10 * MiB;
constexpr size_t WS_WSC = WS_SMALL + 13 * MiB;
constexpr int WSC_AIN = 0, WSC_CIN = 2 * 6144, WSC_GU = 4 * 6144, WSC_MGU = 4 * 6144 + 2 * 11264;
constexpr size_t WS_MLIST = WS_SMALL + 8 * MiB;
constexpr size_t WS_MGATE = WS_SMALL + 9 * MiB;
constexpr size_t WS_Y = WS_QKV;
constexpr int CW_MOECNT = 2048;
constexpr int CW_ATTQ2 = 3420;
constexpr int CW_ATTQ = 3400;
constexpr int CW_KMAX = 3072;
constexpr int MOETAB_OFF = LDSCTL_OFF_FWD + 1024;
constexpr size_t WS_KEXT = WS_SMALL + 4 * MiB;
constexpr size_t WS_END = WS_SMALL + 16 * MiB;
constexpr int CW_TMO = 0, CW_CODE = 1, CW_BAR = 4096;

constexpr int RING_OFF = 0, RING_BYTES = 131072;
constexpr int LDSCTL_OFF = RING_BYTES, MISC_OFF = LDSCTL_OFF + 320;
constexpr int LDS_BYTES = 147456;
#define GAS __attribute__((address_space(1)))
#define LAS __attribute__((address_space(3)))
typedef unsigned short bf16;
typedef unsigned v4u __attribute__((ext_vector_type(4)));
typedef float f32x4 __attribute__((ext_vector_type(4)));
typedef short bf16x8 __attribute__((ext_vector_type(8)));
typedef GAS unsigned gu32;
typedef GAS unsigned long long gu64;
#define RLX_AGENT __ATOMIC_RELAXED, __HIP_MEMORY_SCOPE_AGENT
#define LDS_WAIT() asm volatile("s_waitcnt lgkmcnt(0)" ::: "memory")
#define VM_WAIT() asm volatile("s_waitcnt vmcnt(0)" ::: "memory")
__device__ __forceinline__ unsigned long long rt() { return __builtin_amdgcn_s_memrealtime(); }
__device__ __forceinline__ unsigned f2bf(float f) { unsigned u = __builtin_bit_cast(unsigned, f); return (u + 0x7fffu + ((u >> 16) & 1u)) >> 16; }
__device__ __forceinline__ unsigned pk2(float lo, float hi) { return f2bf(lo) | (f2bf(hi) << 16); }

#define XB_TMO      128
#define XB_XCNT(j)  (256  + 64 * (j))
#define XB_XSUB(j)  (1280 + 64 * (j))
#define XB_XGEN(j)  (2304 + 64 * (j))
#define XB_TOP      3328
#define XB_TOPGEN   3392
#define XCD_BAR_WORDS 3456
#define XB_SPIN_CAP (1u << 24)

__device__ __forceinline__ unsigned xb_ld(unsigned* p)              { return __hip_atomic_load(p, __ATOMIC_RELAXED, __HIP_MEMORY_SCOPE_AGENT); }
__device__ __forceinline__ unsigned xb_add(unsigned* p, unsigned v) { return __hip_atomic_fetch_add(p, v, __ATOMIC_RELAXED, __HIP_MEMORY_SCOPE_AGENT); }
__device__ __forceinline__ unsigned xb_xcc_id() { return (unsigned)__builtin_amdgcn_s_getreg((3 << 11) | 20) & 0xFu; }
#define XB_SPIN(cond, bar) do { unsigned _sp = 0; while (cond) { __builtin_amdgcn_s_sleep(1); \
    if ((++_sp & 255u) == 0u) { if (xb_ld(&(bar)[XB_TMO])) break; if (_sp > XB_SPIN_CAP) { atomicAdd(&(bar)[XB_TMO], 1u); break; } } } } while (0)

struct XcdBarrier {
    unsigned* bar; unsigned x;
    volatile LAS unsigned* st;
};

__device__ __forceinline__ XcdBarrier xcd_barrier_post(unsigned* bar, volatile LAS unsigned* st, const bool t0) {
    XcdBarrier b; b.bar = bar; b.x = xb_xcc_id(); b.st = st;
    if (t0) (void)xb_add(&bar[XB_XCNT(b.x)], 1u);
    return b;
}
__device__ __forceinline__ void xcd_barrier_complete(unsigned* bar, unsigned x, unsigned& nloc, unsigned& nx) {
    const unsigned G = gridDim.x * gridDim.y * gridDim.z;
    unsigned sum, cnt, mine, sp = 0u;
    for (;;) {
        sum = 0u; cnt = 0u; mine = 0u;
#pragma unroll
        for (unsigned j = 0; j < 16; ++j) { const unsigned c = xb_ld(&bar[XB_XCNT(j)]); sum += c; cnt += (c > 0u) ? 1u : 0u; mine = (j == x) ? c : mine; }
        if (sum == G) break;
        __builtin_amdgcn_s_sleep(1);
        if ((++sp & 255u) == 0u) { if (xb_ld(&bar[XB_TMO])) break; if (sp > XB_SPIN_CAP) { atomicAdd(&bar[XB_TMO], 1u); break; } }
    }
    nloc = mine > 0u ? mine : 1u; nx = cnt > 0u ? cnt : 1u;
}

__device__ __forceinline__ void xcd_barrier(const XcdBarrier& b, const bool t0) {
    asm volatile("s_waitcnt vmcnt(0)" ::: "memory");
    __syncthreads();
    if (t0) {
        unsigned* bar = b.bar;
        __builtin_amdgcn_s_waitcnt(0);
        unsigned nloc = b.st[0], nx = b.st[1];
        if (nloc == 0u) { xcd_barrier_complete(bar, b.x, nloc, nx); b.st[0] = nloc; b.st[1] = nx; }
        const unsigned old = xb_add(&bar[XB_XSUB(b.x)], 1u);
        const unsigned gen = old / nloc;
        if (old + 1u == (gen + 1u) * nloc) {
            __builtin_amdgcn_fence(__ATOMIC_RELEASE, "agent");
            asm volatile("s_waitcnt vmcnt(0)" ::: "memory");
            const unsigned og = xb_add(&bar[XB_TOP], 1u);
            const unsigned tg = og / nx;
            if (og + 1u == (tg + 1u) * nx) xb_add(&bar[XB_TOPGEN], 1u);
            else XB_SPIN(xb_ld(&bar[XB_TOPGEN]) == tg, bar);
            __builtin_amdgcn_fence(__ATOMIC_ACQUIRE, "agent");
            xb_add(&bar[XB_XGEN(b.x)], 1u);
            asm volatile("s_waitcnt vmcnt(0)" ::: "memory");
        } else {
            XB_SPIN(xb_ld(&bar[XB_XGEN(b.x)]) == gen, bar);
            __builtin_amdgcn_fence(__ATOMIC_ACQUIRE, "agent");
            asm volatile("s_waitcnt vmcnt(0)" ::: "memory");
        }
    }
    __syncthreads();
}


namespace att {
typedef unsigned short bf16;
typedef short bf16x8 __attribute__((ext_vector_type(8)));
typedef short s16x4 __attribute__((ext_vector_type(4)));
typedef float f32x16 __attribute__((ext_vector_type(16)));
typedef float f32x4 __attribute__((ext_vector_type(4)));
typedef unsigned u32x4 __attribute__((ext_vector_type(4)));
constexpr int NW = 8, QBLK = 32, KVBLK = 64, QB = NW * QBLK, D = 128;
constexpr int LDQ = 6144, LDO = 2048;
constexpr int SHM_V = KVBLK * D * 2, SHM_K = KVBLK * D * 2;
constexpr int LDS_ATT = 2 * SHM_V + 2 * SHM_K + NW * 64 * 4;
constexpr float THR2 = 11.5415603f;
#define KSWZ(row, colB) ((row) * 256 + ((colB) ^ (((row) & 7) << 4)))
#define SBAR() __builtin_amdgcn_sched_barrier(0)
__device__ __forceinline__ int v_st(int k, int c) { const int kk = (k & ~0xC) | ((k & 4) << 1) | ((k & 8) >> 1); return ((kk >> 3) * 4 + (c >> 5)) * 512 + ((kk & 7) * 32 + (c & 31)) * 2; }
__device__ __forceinline__ int v_rd_base(int lane) { return ((lane & 3) << 3) | (((lane >> 2) & 3) << 6) | (((lane >> 4) & 1) << 5) | (((lane >> 5) & 1) << 8); }
constexpr int v_rd_off(int d0, int ks, int half) { return d0 * 512 + ks * 4096 + half * 2048; }
__device__ __forceinline__ int crow(int r, int hi) { return (r & 3) + 8 * (r >> 2) + 4 * hi; }
__device__ __forceinline__ unsigned cvtpk(float lo, float hi) { unsigned r; asm volatile("v_cvt_pk_bf16_f32 %0, %1, %2" : "=v"(r) : "v"(lo), "v"(hi)); return r; }
__device__ __forceinline__ bf16x8 load8(const bf16* p) { return *reinterpret_cast<const bf16x8*>(p); }
__device__ __forceinline__ void mask_tile(f32x16& p0, f32x16& p1, int dq) {
    const float NEG = -__builtin_inff();
#pragma unroll
    for (int r = 0; r < 16; ++r) { const int c = (r & 3) + 8 * (r >> 2);
        if (dq - c < 0) p0[r] = NEG;
        if (dq - c - 32 < 0) p1[r] = NEG; }
}
__device__ __forceinline__ void partialSM(f32x16& p0, f32x16& p1, float& m_reg, float& mn, float& alpha) {
    float pmax = p0[0];
#pragma unroll
    for (int r = 1; r < 16; ++r) pmax = fmaxf(pmax, p0[r]);
#pragma unroll
    for (int r = 0; r < 16; ++r) pmax = fmaxf(pmax, p1[r]);
    { auto rr = __builtin_amdgcn_permlane32_swap(__float_as_uint(pmax), __float_as_uint(pmax), false, false);
      pmax = fmaxf(__uint_as_float(rr[0]), __uint_as_float(rr[1])); }
    if (__builtin_expect(__all((pmax - m_reg) <= THR2), 1)) { mn = m_reg; alpha = 1.f; }
    else { mn = fmaxf(m_reg, pmax); alpha = __builtin_amdgcn_exp2f(m_reg - mn); m_reg = mn; }
#pragma unroll
    for (int r = 0; r < 16; ++r) p0[r] = p0[r] - mn;
#pragma unroll
    for (int r = 0; r < 16; ++r) p1[r] = p1[r] - mn;
#pragma unroll
    for (int r = 0; r < 16; ++r) p0[r] = __builtin_amdgcn_exp2f(p0[r]);
}
#define PK4(P, B_, OUT) do { unsigned a0 = cvtpk(P[B_+0], P[B_+1]), a1 = cvtpk(P[B_+2], P[B_+3]);                          \
        unsigned b0 = cvtpk(P[B_+4], P[B_+5]), b1 = cvtpk(P[B_+6], P[B_+7]);                                             \
        auto r0 = __builtin_amdgcn_permlane32_swap(a0, b0, false, false); auto r1 = __builtin_amdgcn_permlane32_swap(a1, b1, false, false); \
        u32x4 w = {r0[0], r1[0], r0[1], r1[1]}; OUT = *reinterpret_cast<bf16x8*>(&w); } while (0)
__device__ __forceinline__ void finishSM(f32x16& p0, f32x16& p1, float alpha, float& l_reg, bf16x8& pa0, bf16x8& pa1, bf16x8& pa2, bf16x8& pa3) {
#pragma unroll
    for (int r = 0; r < 16; ++r) p1[r] = __builtin_amdgcn_exp2f(p1[r]);
    float ps = 0;
#pragma unroll
    for (int r = 0; r < 16; ++r) ps += p0[r];
#pragma unroll
    for (int r = 0; r < 16; ++r) ps += p1[r];
    { auto rr = __builtin_amdgcn_permlane32_swap(__float_as_uint(ps), __float_as_uint(ps), false, false);
      ps = __uint_as_float(rr[0]) + __uint_as_float(rr[1]); }
    l_reg = l_reg * alpha + ps;
    PK4(p0, 0, pa0); PK4(p0, 8, pa1); PK4(p1, 0, pa2); PK4(p1, 8, pa3);
}
struct SbConst { bf16x8 pa0, pa1, ones; };
__device__ __forceinline__ SbConst sb_consts(int r32, int hi) {
    SbConst c; u32x4 w0, w1;
#pragma unroll
    for (int q = 0; q < 4; ++q) { unsigned a = 0, b = 0;
#pragma unroll
        for (int e = 0; e < 2; ++e) { const int jj = 2 * q + e; const int k0 = 8 * (jj >> 2) + 4 * hi + (jj & 3);
            if (k0 > r32) a |= 0x3F80u << (16 * e);
            if (16 + k0 > r32) b |= 0x3F80u << (16 * e); }
        w0[q] = a; w1[q] = b; }
    c.pa0 = *reinterpret_cast<bf16x8*>(&w0); c.pa1 = *reinterpret_cast<bf16x8*>(&w1);
    u32x4 o = {0x3F803F80u, 0x3F803F80u, 0x3F803F80u, 0x3F803F80u}; c.ones = *reinterpret_cast<bf16x8*>(&o);
    return c;
}
__device__ __forceinline__ void sb_math(f32x16& p0, f32x16& p1, float& R, bool key0_valid, int hi, const SbConst& C, bf16x8& pa0, bf16x8& pa1, bf16x8& pa2, bf16x8& pa3) {
    const float y00 = p0[0];
    f32x16 l0, l1;
#pragma unroll
    for (int r = 0; r < 16; ++r) { const float y = p0[r]; const float u = __builtin_amdgcn_logf(1.0f + __builtin_amdgcn_exp2f(-fabsf(y))); const float ln = fmaxf(y, 0.f) + u;
        l0[r] = (y == -__builtin_inff()) ? 0.f : ln; p0[r] = (y - ln) + R; }
#pragma unroll
    for (int r = 0; r < 16; ++r) { const float y = p1[r]; const float u = __builtin_amdgcn_logf(1.0f + __builtin_amdgcn_exp2f(-fabsf(y))); const float ln = fmaxf(y, 0.f) + u;
        l1[r] = (y == -__builtin_inff()) ? 0.f : ln; p1[r] = (y - ln) + R; }
    bf16x8 b00, b01, b10, b11;
    { u32x4 w = {cvtpk(-l0[0], -l0[1]), cvtpk(-l0[2], -l0[3]), cvtpk(-l0[4], -l0[5]), cvtpk(-l0[6], -l0[7])}; b00 = *reinterpret_cast<bf16x8*>(&w); }
    { u32x4 w = {cvtpk(-l0[8], -l0[9]), cvtpk(-l0[10], -l0[11]), cvtpk(-l0[12], -l0[13]), cvtpk(-l0[14], -l0[15])}; b01 = *reinterpret_cast<bf16x8*>(&w); }
    { u32x4 w = {cvtpk(-l1[0], -l1[1]), cvtpk(-l1[2], -l1[3]), cvtpk(-l1[4], -l1[5]), cvtpk(-l1[6], -l1[7])}; b10 = *reinterpret_cast<bf16x8*>(&w); }
    { u32x4 w = {cvtpk(-l1[8], -l1[9]), cvtpk(-l1[10], -l1[11]), cvtpk(-l1[12], -l1[13]), cvtpk(-l1[14], -l1[15])}; b11 = *reinterpret_cast<bf16x8*>(&w); }
    p0 = __builtin_amdgcn_mfma_f32_32x32x16_bf16(C.pa0, b00, p0, 0, 0, 0);
    p0 = __builtin_amdgcn_mfma_f32_32x32x16_bf16(C.pa1, b01, p0, 0, 0, 0);
    p0 = __builtin_amdgcn_mfma_f32_32x32x16_bf16(C.ones, b10, p0, 0, 0, 0);
    p0 = __builtin_amdgcn_mfma_f32_32x32x16_bf16(C.ones, b11, p0, 0, 0, 0);
    p1 = __builtin_amdgcn_mfma_f32_32x32x16_bf16(C.pa0, b10, p1, 0, 0, 0);
    p1 = __builtin_amdgcn_mfma_f32_32x32x16_bf16(C.pa1, b11, p1, 0, 0, 0);
    { const float rn = key0_valid ? (p0[0] - y00) : R; auto rr = __builtin_amdgcn_permlane32_swap(__float_as_uint(rn), __float_as_uint(rn), false, false); R = __uint_as_float(rr[0]); }
#pragma unroll
    for (int r = 0; r < 16; ++r) p0[r] = __builtin_amdgcn_exp2f(p0[r]);
#pragma unroll
    for (int r = 0; r < 16; ++r) p1[r] = __builtin_amdgcn_exp2f(p1[r]);
    PK4(p0, 0, pa0); PK4(p0, 8, pa1); PK4(p1, 0, pa2); PK4(p1, 8, pa3);
}
template <int KB, int MODE>
__device__ __forceinline__ void qkt(f32x16& p0, f32x16& p1, const char* K_lds, int r32, int hi, const bf16x8* qr, bool act, const bf16* kx, float& bl) {
    if (!act) { const float NEG = -__builtin_inff();
#pragma unroll
        for (int r = 0; r < 16; ++r) { p0[r] = NEG; p1[r] = NEG; } return; }
    float e0 = 0.f, e1 = 0.f;
    if (MODE == 0) { const float* cx = (const float*)kx; e0 = hi ? 0.f : -cx[0]; e1 = hi ? 0.f : -cx[32]; bl = e0; }
    p0 = f32x16{}; p1 = f32x16{};
    const char* kb[4];
#pragma unroll
    for (int dd = 0; dd < 4; ++dd) kb[dd] = K_lds + KB * SHM_K + KSWZ(r32, (dd * 16 + hi * 8) * 2);
#pragma unroll
    for (int d0 = 0; d0 < 8; ++d0) { const char* a = kb[d0 & 3] + (d0 >> 2) * 128;
        bf16x8 b0 = *reinterpret_cast<const bf16x8*>(a);
        bf16x8 b1 = *reinterpret_cast<const bf16x8*>(a + 32 * 256);
        p0 = __builtin_amdgcn_mfma_f32_32x32x16_bf16(b0, qr[d0], p0, 0, 0, 0);
        p1 = __builtin_amdgcn_mfma_f32_32x32x16_bf16(b1, qr[d0], p1, 0, 0, 0); }
    if (MODE == 0) { const float one = hi ? 0.f : 1.0f;
        p0 = __builtin_amdgcn_mfma_f32_32x32x2f32(e0, one, p0, 0, 0, 0);
        p1 = __builtin_amdgcn_mfma_f32_32x32x2f32(e1, one, p1, 0, 0, 0); }
}
template <int VB, bool SK>
__device__ __forceinline__ void pv_tile(f32x16* o, int vb0, bf16x8 pa0, bf16x8 pa1, bf16x8 pa2, bf16x8 pa3, bool act) {
    if (SK && !act) return;
#define TRRD(dst, off) asm volatile("ds_read_b64_tr_b16 %0, %1 offset:%2" : "=&v"(dst) : "v"(vb0), "i"(off) : "memory")
#define PV_D0(d0) do { s16x4 l0, l1, l2, l3, h0, h1, h2, h3; constexpr int b_ = VB * SHM_V + v_rd_off(d0, 0, 0);   \
        TRRD(l0, b_); TRRD(h0, b_ + 2048); TRRD(l1, b_ + 4096); TRRD(h1, b_ + 6144); TRRD(l2, b_ + 8192); TRRD(h2, b_ + 10240); TRRD(l3, b_ + 12288); TRRD(h3, b_ + 14336); \
        asm volatile("s_waitcnt lgkmcnt(0)" ::: "memory"); SBAR();   \
        o[d0] = __builtin_amdgcn_mfma_f32_32x32x16_bf16(pa0, (bf16x8){l0[0], l0[1], l0[2], l0[3], h0[0], h0[1], h0[2], h0[3]}, o[d0], 0, 0, 0);   \
        o[d0] = __builtin_amdgcn_mfma_f32_32x32x16_bf16(pa1, (bf16x8){l1[0], l1[1], l1[2], l1[3], h1[0], h1[1], h1[2], h1[3]}, o[d0], 0, 0, 0);   \
        o[d0] = __builtin_amdgcn_mfma_f32_32x32x16_bf16(pa2, (bf16x8){l2[0], l2[1], l2[2], l2[3], h2[0], h2[1], h2[2], h2[3]}, o[d0], 0, 0, 0);   \
        o[d0] = __builtin_amdgcn_mfma_f32_32x32x16_bf16(pa3, (bf16x8){l3[0], l3[1], l3[2], l3[3], h3[0], h3[1], h3[2], h3[3]}, o[d0], 0, 0, 0); } while (0)
    PV_D0(0); PV_D0(1); PV_D0(2); PV_D0(3);
#undef PV_D0
#undef TRRD
}
__device__ __forceinline__ unsigned pk_e4m3x4(float a, float b, float c, float d) { int p = 0; p = __builtin_amdgcn_cvt_pk_fp8_f32(a, b, p, false); p = __builtin_amdgcn_cvt_pk_fp8_f32(c, d, p, true); return (unsigned)p; }
struct BlockRef { const bf16* Qb; bf16* Ob; const bf16* KX; int P0; };
struct Seam { bf16x8 qr[8]; bf16x8 st_v0, st_v1, st_k0, st_k1; };
#define ROW(p, k0, rr) ((const bf16*)((const char*)(Qhb) + (unsigned)(((k0) + (rr)) * (LDQ * 2) + sc * 2 + (p))))
#define VMW() asm volatile("s_waitcnt vmcnt(0)" ::: "memory")
#define VMWN(n) asm volatile("s_waitcnt vmcnt(%0)" :: "i"(n) : "memory")
#define SLOAD_H(Kp, Vp, k0) do { const unsigned ro_ = (unsigned)(((k0) + sr) * (LDQ * 2) + sc * 2);                    \
                         S.st_v0 = load8((const bf16*)((const char*)(Qhb) + (ro_ + 4096u))); S.st_v1 = load8((const bf16*)((const char*)(Qhb) + (ro_ + 4096u + 32u * (LDQ * 2))));              \
                         S.st_k0 = load8((const bf16*)((const char*)(Qhb) + (ro_ + 2048u))); S.st_k1 = load8((const bf16*)((const char*)(Qhb) + (ro_ + 2048u + 32u * (LDQ * 2)))); } while (0)
#define SWRITE_HK(bf) do { *(bf16x8*)(K_lds + (bf) * SHM_K + kws) = S.st_k0; *(bf16x8*)(K_lds + (bf) * SHM_K + kws + 32 * 256) = S.st_k1; } while (0)
#define SWRITE_HV(bf) do { *(bf16x8*)(V_lds + (bf) * SHM_V + vst0) = S.st_v0; *(bf16x8*)(V_lds + (bf) * SHM_V + vst1) = S.st_v1; } while (0)
#define SWRITE_H(bf) do { SWRITE_HV(bf); SWRITE_HK(bf); } while (0)
__device__ __forceinline__ int first_tile(int P0) { return ((P0 + QB - 1) / KVBLK) * KVBLK; }
__device__ __forceinline__ void attn_prime(const BlockRef& cur, char* lds, Seam& S, const int wv) {
    const bf16* Qhb = cur.Qb;
    int tid_ = wv * 64 + lane_id_asm(); asm volatile("" : "+v"(tid_));
    const int tid = tid_, wid = __builtin_amdgcn_readfirstlane(tid >> 6), lane = tid & 63, r32 = lane & 31, hi = lane >> 5;
    const int sr = tid >> 4, sc = (tid & 15) * 8, kws = KSWZ(sr, sc * 2); char* K_lds = lds + 2 * SHM_V;
    const int kb0 = first_tile(cur.P0);
#pragma unroll
    for (int d0 = 0; d0 < 8; ++d0) S.qr[d0] = load8((const bf16*)((const char*)Qhb + (unsigned)((cur.P0 + wid * QBLK + r32) * (LDQ * 2) + d0 * 32 + hi * 16)));
    SLOAD_H(0, 0, kb0); VMW(); SWRITE_HK(0);
    __syncthreads();
}
template <int MODE, bool FEARLY, bool O8>
__device__ __forceinline__ void attn_block(const BlockRef& cur, const int nxtP0, const bf16* nxtQb, char* lds, Seam& S, const unsigned* kmax4, const int wv) {
    const bf16* Qhb = cur.Qb;
    constexpr bool SK = (MODE == 1) || FEARLY;
    int tid_ = wv * 64 + lane_id_asm(); asm volatile("" : "+v"(tid_));
    const int tid = tid_, wid = __builtin_amdgcn_readfirstlane(tid >> 6), lane = tid & 63, r32 = lane & 31, hi = lane >> 5;
    const int NT = first_tile(cur.P0) / KVBLK + 1;
    const int kbn = first_tile(nxtP0);
    const int qlo = cur.P0 + wid * QBLK, qm = qlo + r32 - 4 * hi - (MODE == 1 ? 1 : 0);
    char* V_lds = lds; char* K_lds = lds + 2 * SHM_V;
    float* ws = (float*)(lds + 2 * SHM_V + 2 * SHM_K) + wid * 64; float* li_l = ws, * al_l = ws + 32;
    const int li_rd = (int)(uintptr_t)li_l + 16 * hi, al_rd = li_rd + 128;
    float m_reg = -1e30f, l_reg = 0, Rsb = 0; f32x16 o[4] = {};
    const int sr = tid >> 4, sc = (tid & 15) * 8, vst0 = v_st(sr, sc), vst1 = v_st(32 + sr, sc), kws = KSWZ(sr, sc * 2);
    const int vb0 = (int)(uintptr_t)V_lds + v_rd_base(lane);
    SbConst SC; if (MODE == 1) SC = sb_consts(r32, hi);
    volatile int* flags = (volatile int*)(lds + 2 * SHM_V + 2 * SHM_K + NW * 64 * 4);
    float ubq = 0.f, bprev = 3.0e38f; bool fdone = false, alld = false; int nskip = 0;
    if (FEARLY) {
        if (lane == 0) flags[wid] = 0;
        float q2[4];
#pragma unroll
        for (int w = 0; w < 4; ++w) { float a = 0.f;
#pragma unroll
            for (int dd = 0; dd < 2; ++dd) { const bf16x8 f = S.qr[2 * w + dd];
#pragma unroll
                for (int j = 0; j < 8; ++j) { const float x = __uint_as_float(((unsigned)(unsigned short)f[j]) << 16); a += x * x; } }
            auto rr = __builtin_amdgcn_permlane32_swap(__float_as_uint(a), __float_as_uint(a), false, false); q2[w] = __uint_as_float(rr[0]) + __uint_as_float(rr[1]); }
        const unsigned kv = kmax4[lane & 3];
#pragma unroll
        for (int w = 0; w < 4; ++w) { const float k2 = __uint_as_float((unsigned)__builtin_amdgcn_readlane((int)kv, w)); ubq += __builtin_sqrtf(q2[w] * k2); }
        ubq *= 1.02f;
    }
#define LROW16(dst, basev) do { _Pragma("unroll") for (int r_ = 0; r_ < 16; ++r_) asm volatile("ds_read_b32 %0, %1 offset:%2" : "=v"(dst[r_]) : "v"(basev), "i"(4 * ((r_ & 3) + 8 * (r_ >> 2))) : "memory"); \
        asm volatile("s_waitcnt lgkmcnt(0)" ::: "memory"); SBAR(); } while (0)
#define RESC(a) do { if (MODE == 0) { if (__any((a) < 1.f)) { if (hi == 0) al_l[r32] = (a); asm volatile("s_waitcnt lgkmcnt(0)" ::: "memory");              \
                     float av_[16]; LROW16(av_, al_rd); for (int d_ = 0; d_ < 4; ++d_) for (int r = 0; r < 16; ++r) o[d_][r] *= av_[r]; } } } while (0)
#define KBASE(t) ((NT - 1 - (t)) * KVBLK)
#define ACT(t) ((KBASE(t) <= qlo + QBLK - 1) && !(FEARLY && fdone))
#define KXP(t) ((const bf16*)((const char*)cur.KX + (unsigned)((KBASE(t) + r32) * 4)))
#define FCHK() do { if (FEARLY) { if (!fdone) fdone = __all((ubq + bprev) - m_reg < (float)(FOX_CUT)) != 0; if (fdone) { if (++nskip == 2 && lane == 0) flags[wid] = 1; } } } while (0)
#define BLUPD(b) do { if (FEARLY) bprev = __uint_as_float((unsigned)__builtin_amdgcn_readlane((int)__float_as_uint(b), 0)); } while (0)
#define MASKT(P0_, P1_, t) do { const int kb_ = KBASE(t); if ((!SK || ACT(t)) && (kb_ + KVBLK - 1 > qlo - (MODE == 1 ? 1 : 0))) mask_tile(P0_, P1_, qm - kb_); } while (0)
#define FIN(PY0, PY1, alY, ty) do { if (MODE == 0) finishSM(PY0, PY1, alY, l_reg, pa0, pa1, pa2, pa3); else if (ACT(ty)) sb_math(PY0, PY1, Rsb, (qlo + r32) > KBASE(ty), hi, SC, pa0, pa1, pa2, pa3); } while (0)
#define PSM(PX0, PX1, mnX, alX) do { if (MODE == 0) partialSM(PX0, PX1, m_reg, mnX, alX); } while (0)
    constexpr int NQL = 8;
#define SEAM_K0() do { VMWN(NQL); SWRITE_HK(0); SBAR(); } while (0)
    f32x16 pA0, pA1, pB0, pB1; float mnA = 0, mnB = 0, alA = 1, alB = 1; bf16x8 pa0, pa1, pa2, pa3;
    SWRITE_HV(0); SBAR();
    if (NT > 1) { SLOAD_H(0, 0, KBASE(1)); }
    float bl = 0.f;
    SBAR(); qkt<0, MODE>(pA0, pA1, K_lds, r32, hi, S.qr, ACT(0), KXP(0), bl); if (ACT(0)) BLUPD(bl);
    MASKT(pA0, pA1, 0); PSM(pA0, pA1, mnA, alA);
    if (NT > 1) { VMW(); SWRITE_H(1); }
    __syncthreads();
#define HALF_STEP(PX0, PX1, mnX, alX, PY0, PY1, alY, t, KB, VB, SB) do {                                                      \
        FCHK(); SBAR(); qkt<KB, MODE>(PX0, PX1, K_lds, r32, hi, S.qr, ACT(t), KXP(t), bl); if (ACT(t)) BLUPD(bl);                                            \
        FIN(PY0, PY1, alY, (t) - 1); SBAR();                                                           \
        if ((t) + 1 < NT) { SLOAD_H(0, 0, KBASE((t) + 1)); SBAR(); }                                               \
        pv_tile<VB, SK>(o, vb0, pa0, pa1, pa2, pa3, ACT((t) - 1)); MASKT(PX0, PX1, (t)); PSM(PX0, PX1, mnX, alX);                                        \
        __syncthreads();                                                                                                      \
        if (FEARLY) { int c_ = 0; for (int w_ = 0; w_ < NW; ++w_) c_ += flags[w_]; alld = (c_ == NW); }     \
        if ((t) + 1 < NT) { VMW(); SWRITE_H(SB); }                                                                          \
        RESC(alX); __syncthreads(); } while (0)
    for (int t = 1; t + 1 < NT; t += 2) {
        HALF_STEP(pB0, pB1, mnB, alB, pA0, pA1, alA, t, 1, 0, 0);
        HALF_STEP(pA0, pA1, mnA, alA, pB0, pB1, alB, t + 1, 0, 1, 1);
        if (FEARLY && alld) break;
    }
    const bool even = (NT & 1) == 0;
    if (even && !alld) { FCHK(); SBAR(); qkt<1, MODE>(pB0, pB1, K_lds, r32, hi, S.qr, ACT(NT - 1), KXP(NT - 1), bl); SBAR(); }
    Qhb = nxtQb;
    SLOAD_H(0, 0, kbn); SBAR();
#pragma unroll
    for (int d0 = 0; d0 < 8; ++d0) S.qr[d0] = load8((const bf16*)((const char*)Qhb + (unsigned)((nxtP0 + wid * QBLK + r32) * (LDQ * 2) + d0 * 32 + hi * 16)));
    SBAR();
    if (!alld) {
    FIN(pA0, pA1, alA, (even ? NT - 2 : NT - 1)); SBAR();
    pv_tile<0, SK>(o, vb0, pa0, pa1, pa2, pa3, ACT(even ? NT - 2 : NT - 1));
    if (even) { MASKT(pB0, pB1, NT - 1); PSM(pB0, pB1, mnB, alB); __syncthreads(); RESC(alB);
        FIN(pB0, pB1, alB, NT - 1); SBAR(); pv_tile<1, SK>(o, vb0, pa0, pa1, pa2, pa3, ACT(NT - 1)); }
    }
    SBAR(); SEAM_K0();
    float rli[16];
    if (MODE == 0) { if (hi == 0) li_l[r32] = l_reg; asm volatile("s_waitcnt lgkmcnt(0)" ::: "memory");
        LROW16(rli, li_rd);
#pragma unroll
        for (int r = 0; r < 16; ++r) rli[r] = __builtin_amdgcn_rcpf(rli[r]); }
    else {
#pragma unroll
        for (int r = 0; r < 16; ++r) rli[r] = 1.f; }
    char* Ow = (char*)cur.Ob + (size_t)(cur.P0 + wid * QBLK) * (O8 ? LDO : LDO * 2);
    const int hi_e = lane_id_asm() >> 5;
#pragma unroll
    for (int r = 0; r < 16; ++r) { const int orow = crow(r, hi_e);
#pragma unroll
        for (int d0 = 0; d0 < 4; ++d0) { const float v = o[d0][r] * rli[r];
            if (O8) { const float v16 = v * 16.0f;
                const float v1 = __uint_as_float((unsigned)__builtin_amdgcn_mov_dpp((int)__float_as_uint(v16), 0x55, 0xf, 0xf, true)), v2 = __uint_as_float((unsigned)__builtin_amdgcn_mov_dpp((int)__float_as_uint(v16), 0xAA, 0xf, 0xf, true)),
                            v3 = __uint_as_float((unsigned)__builtin_amdgcn_mov_dpp((int)__float_as_uint(v16), 0xFF, 0xf, 0xf, true));
                if ((r32 & 3) == 0) *(unsigned*)(Ow + (unsigned)(orow * LDO + d0 * 32 + r32)) = pk_e4m3x4(v16, v1, v2, v3); }
            else {
            const float vn = __uint_as_float((unsigned)__builtin_amdgcn_mov_dpp((int)__float_as_uint(v), 0xB1, 0xf, 0xf, true));
            if ((r32 & 1) == 0) *(unsigned*)(Ow + (unsigned)(orow * (LDO * 2) + (d0 * 32 + r32) * 2)) = cvtpk(v, vn); } } }
    __syncthreads();
#undef RESC
#undef LROW16
#undef KBASE
#undef ACT
#undef KXP
#undef FCHK
#undef BLUPD
#undef MASKT
#undef FIN
#undef PSM
#undef SEAM_K0
#undef HALF_STEP
}
#undef ROW
#undef VMW
#undef VMWN
#undef SLOAD_H
#undef SWRITE_HK
#undef SWRITE_HV
#undef SWRITE_H
#undef PK4
constexpr float SB_CUT = (float)(SB_CUT_LOG2);
#define ROW(p, k0, rr) ((const bf16*)((const char*)(Qhb) + (unsigned)(((k0) + (rr)) * (LDQ * 2) + sc * 2 + (p))))
#define VMW() asm volatile("s_waitcnt vmcnt(0)" ::: "memory")
#define VMWN(n) asm volatile("s_waitcnt vmcnt(%0)" :: "i"(n) : "memory")
#define SLOAD_H(Kp, Vp, k0) do { const unsigned ro_ = (unsigned)(((k0) + sr) * (LDQ * 2) + sc * 2);                    \
                         S.st_v0 = load8((const bf16*)((const char*)(Qhb) + (ro_ + 4096u))); S.st_v1 = load8((const bf16*)((const char*)(Qhb) + (ro_ + 4096u + 32u * (LDQ * 2))));              \
                         S.st_k0 = load8((const bf16*)((const char*)(Qhb) + (ro_ + 2048u))); S.st_k1 = load8((const bf16*)((const char*)(Qhb) + (ro_ + 2048u + 32u * (LDQ * 2)))); } while (0)
#define SWRITE_HK(bf) do { *(bf16x8*)(K_lds + (bf) * SHM_K + kws) = S.st_k0; *(bf16x8*)(K_lds + (bf) * SHM_K + kws + 32 * 256) = S.st_k1; } while (0)
#define SWRITE_HV(bf) do { *(bf16x8*)(V_lds + (bf) * SHM_V + vst0) = S.st_v0; *(bf16x8*)(V_lds + (bf) * SHM_V + vst1) = S.st_v1; } while (0)
#define PK4(P, B_, OUT) do { unsigned a0 = cvtpk(P[B_+0], P[B_+1]), a1 = cvtpk(P[B_+2], P[B_+3]);                          \
        unsigned b0 = cvtpk(P[B_+4], P[B_+5]), b1 = cvtpk(P[B_+6], P[B_+7]);                                             \
        auto r0 = __builtin_amdgcn_permlane32_swap(a0, b0, false, false); auto r1 = __builtin_amdgcn_permlane32_swap(a1, b1, false, false); \
        u32x4 w = {r0[0], r1[0], r0[1], r1[1]}; OUT = *reinterpret_cast<bf16x8*>(&w); } while (0)
template <bool EARLY, bool O8>
__device__ __forceinline__ void sb_block(const BlockRef& cur, const int nxtP0, const bf16* nxtQb, char* lds, Seam& S, const int wv) {
    const bf16* Qhb = cur.Qb;
    int tid_ = wv * 64 + lane_id_asm(); asm volatile("" : "+v"(tid_));
    const int tid = tid_, wid = __builtin_amdgcn_readfirstlane(tid >> 6), lane = tid & 63, r32 = lane & 31, hi = lane >> 5;
    const int NT = first_tile(cur.P0) / KVBLK + 1;
    const int kbn = first_tile(nxtP0);
    const int qlo = cur.P0 + wid * QBLK, qm = qlo + r32 - 4 * hi - 1;
    char* V_lds = lds; char* K_lds = lds + 2 * SHM_V;
    volatile int* flags = (volatile int*)(lds + 2 * SHM_V + 2 * SHM_K);
    float Rsb = 0; f32x16 o[4] = {};
    const int sr = tid >> 4, sc = (tid & 15) * 8, vst0 = v_st(sr, sc), vst1 = v_st(32 + sr, sc), kws = KSWZ(sr, sc * 2);
    const int vb0 = (int)(uintptr_t)V_lds + v_rd_base(lane);
    if (EARLY && lane == 0) flags[wid] = 0;
    SWRITE_HV(0);
    bool wdone = false;
    for (int t = 0; t < NT; ++t) {
        const int kb_ = (NT - 1 - t) * KVBLK, bsel = t & 1;
        const bool more = t + 1 < NT;
        if (more) SLOAD_H(0, 0, kb_ - KVBLK);
        SBAR();
        const bool act = (kb_ <= qlo + QBLK - 1) && !wdone;
        bf16x8 pa0, pa1, pa2, pa3;
        if (act) {
            f32x16 p0 = {}, p1 = {};
            const char* kb[4];
#pragma unroll
            for (int dd = 0; dd < 4; ++dd) kb[dd] = K_lds + bsel * SHM_K + KSWZ(r32, (dd * 16 + hi * 8) * 2);
#pragma unroll
            for (int d0 = 0; d0 < 8; ++d0) { const char* a = kb[d0 & 3] + (d0 >> 2) * 128;
                bf16x8 b0 = *reinterpret_cast<const bf16x8*>(a);
                bf16x8 b1 = *reinterpret_cast<const bf16x8*>(a + 32 * 256);
                p0 = __builtin_amdgcn_mfma_f32_32x32x16_bf16(b0, S.qr[d0], p0, 0, 0, 0);
                p1 = __builtin_amdgcn_mfma_f32_32x32x16_bf16(b1, S.qr[d0], p1, 0, 0, 0); }
            if (kb_ + KVBLK - 1 > qlo - 1) mask_tile(p0, p1, qm - kb_);
            const float y00 = p0[0];
            bf16x8 b00, b01, b10, b11;
#define SBL(P, r) ({ const float y_ = P[r]; const float ln_ = fmaxf(y_, 0.f) + __builtin_amdgcn_logf(1.0f + __builtin_amdgcn_exp2f(-fabsf(y_))); P[r] = (y_ - ln_) + Rsb; -ln_; })
            { float n[16];
#pragma unroll
              for (int r = 0; r < 16; ++r) n[r] = SBL(p1, r);
              u32x4 w = {cvtpk(n[0], n[1]), cvtpk(n[2], n[3]), cvtpk(n[4], n[5]), cvtpk(n[6], n[7])}; b10 = *reinterpret_cast<bf16x8*>(&w);
              u32x4 w2 = {cvtpk(n[8], n[9]), cvtpk(n[10], n[11]), cvtpk(n[12], n[13]), cvtpk(n[14], n[15])}; b11 = *reinterpret_cast<bf16x8*>(&w2); }
            { float n[16];
#pragma unroll
              for (int r = 0; r < 16; ++r) n[r] = SBL(p0, r);
              u32x4 w = {cvtpk(n[0], n[1]), cvtpk(n[2], n[3]), cvtpk(n[4], n[5]), cvtpk(n[6], n[7])}; b00 = *reinterpret_cast<bf16x8*>(&w);
              u32x4 w2 = {cvtpk(n[8], n[9]), cvtpk(n[10], n[11]), cvtpk(n[12], n[13]), cvtpk(n[14], n[15])}; b01 = *reinterpret_cast<bf16x8*>(&w2); }
#undef SBL
            { const SbConst C = sb_consts(r32, hi);
              p1 = __builtin_amdgcn_mfma_f32_32x32x16_bf16(C.pa0, b10, p1, 0, 0, 0);
              p1 = __builtin_amdgcn_mfma_f32_32x32x16_bf16(C.pa1, b11, p1, 0, 0, 0);
              p0 = __builtin_amdgcn_mfma_f32_32x32x16_bf16(C.pa0, b00, p0, 0, 0, 0);
              p0 = __builtin_amdgcn_mfma_f32_32x32x16_bf16(C.pa1, b01, p0, 0, 0, 0);
              p0 = __builtin_amdgcn_mfma_f32_32x32x16_bf16(C.ones, b10, p0, 0, 0, 0);
              p0 = __builtin_amdgcn_mfma_f32_32x32x16_bf16(C.ones, b11, p0, 0, 0, 0); }
            { const float rn = ((qlo + r32) > kb_) ? (p0[0] - y00) : Rsb; auto rr = __builtin_amdgcn_permlane32_swap(__float_as_uint(rn), __float_as_uint(rn), false, false); Rsb = __uint_as_float(rr[0]); }
#pragma unroll
            for (int r = 0; r < 16; ++r) p0[r] = __builtin_amdgcn_exp2f(p0[r]);
#pragma unroll
            for (int r = 0; r < 16; ++r) p1[r] = __builtin_amdgcn_exp2f(p1[r]);
            PK4(p0, 0, pa0); PK4(p0, 8, pa1); PK4(p1, 0, pa2); PK4(p1, 8, pa3);
            if (EARLY) { wdone = __all(Rsb < SB_CUT) != 0; if (wdone && lane == 0) flags[wid] = 1; }
        }
        if (t == 0) __syncthreads();
        if (act) {
            const int vbt = vb0 + bsel * SHM_V;
#define TRRD(dst, off) asm volatile("ds_read_b64_tr_b16 %0, %1 offset:%2" : "=&v"(dst) : "v"(vbt), "i"(off) : "memory")
#define PV_D0(d0) do { s16x4 l0, l1, l2, l3, h0, h1, h2, h3; constexpr int b_ = v_rd_off(d0, 0, 0);   \
        TRRD(l0, b_); TRRD(h0, b_ + 2048); TRRD(l1, b_ + 4096); TRRD(h1, b_ + 6144); TRRD(l2, b_ + 8192); TRRD(h2, b_ + 10240); TRRD(l3, b_ + 12288); TRRD(h3, b_ + 14336); \
        asm volatile("s_waitcnt lgkmcnt(0)" ::: "memory"); SBAR();   \
        o[d0] = __builtin_amdgcn_mfma_f32_32x32x16_bf16(pa0, (bf16x8){l0[0], l0[1], l0[2], l0[3], h0[0], h0[1], h0[2], h0[3]}, o[d0], 0, 0, 0);   \
        o[d0] = __builtin_amdgcn_mfma_f32_32x32x16_bf16(pa1, (bf16x8){l1[0], l1[1], l1[2], l1[3], h1[0], h1[1], h1[2], h1[3]}, o[d0], 0, 0, 0);   \
        o[d0] = __builtin_amdgcn_mfma_f32_32x32x16_bf16(pa2, (bf16x8){l2[0], l2[1], l2[2], l2[3], h2[0], h2[1], h2[2], h2[3]}, o[d0], 0, 0, 0);   \
        o[d0] = __builtin_amdgcn_mfma_f32_32x32x16_bf16(pa3, (bf16x8){l3[0], l3[1], l3[2], l3[3], h3[0], h3[1], h3[2], h3[3]}, o[d0], 0, 0, 0); } while (0)
            PV_D0(0); PV_D0(1); PV_D0(2); PV_D0(3);
#undef PV_D0
#undef TRRD
        }
        asm volatile("s_waitcnt lgkmcnt(0)" ::: "memory");
        __syncthreads();
        bool alldone = false;
        if (EARLY) { int c = 0;
#pragma unroll
            for (int w = 0; w < NW; ++w) c += flags[w];
            alldone = (c == NW); }
        if (more && !alldone) { VMW(); SWRITE_HV(bsel ^ 1); SWRITE_HK(bsel ^ 1); }
        __syncthreads();
        if (alldone) break;
    }
    Qhb = nxtQb;
    SLOAD_H(0, 0, kbn); SBAR();
#pragma unroll
    for (int d0 = 0; d0 < 8; ++d0) S.qr[d0] = load8((const bf16*)((const char*)Qhb + (unsigned)((nxtP0 + wid * QBLK + r32) * (LDQ * 2) + d0 * 32 + hi * 16)));
    SBAR();
    VMWN(8); SWRITE_HK(0); SBAR();
    char* Ow = (char*)cur.Ob + (size_t)(cur.P0 + wid * QBLK) * (O8 ? LDO : LDO * 2);
    const int hi_e = lane_id_asm() >> 5;
#pragma unroll
    for (int r = 0; r < 16; ++r) { const int orow = crow(r, hi_e);
#pragma unroll
        for (int d0 = 0; d0 < 4; ++d0) { const float v = o[d0][r];
            if (O8) { const float v16 = v * 16.0f;
                const float v1 = __uint_as_float((unsigned)__builtin_amdgcn_mov_dpp((int)__float_as_uint(v16), 0x55, 0xf, 0xf, true)), v2 = __uint_as_float((unsigned)__builtin_amdgcn_mov_dpp((int)__float_as_uint(v16), 0xAA, 0xf, 0xf, true)),
                            v3 = __uint_as_float((unsigned)__builtin_amdgcn_mov_dpp((int)__float_as_uint(v16), 0xFF, 0xf, 0xf, true));
                if ((r32 & 3) == 0) *(unsigned*)(Ow + (unsigned)(orow * LDO + d0 * 32 + r32)) = pk_e4m3x4(v16, v1, v2, v3); }
            else {
            const float vn = __uint_as_float((unsigned)__builtin_amdgcn_mov_dpp((int)__float_as_uint(v), 0xB1, 0xf, 0xf, true));
            if ((r32 & 1) == 0) *(unsigned*)(Ow + (unsigned)(orow * (LDO * 2) + (d0 * 32 + r32) * 2)) = cvtpk(v, vn); } } }
    __syncthreads();
}
#undef ROW
#undef VMW
#undef VMWN
#undef SLOAD_H
#undef SWRITE_HK
#undef SWRITE_HV
#undef PK4
template <int MODE, bool EARLY, bool O8>
__device__ __forceinline__ void attn_stream(char* lds, const bf16* QKV, const bf16* KXall, bf16* O, int L, const unsigned* kmax, const int wv) {
    const int xcd = L & 7, k = L >> 3, bh = xcd * 4 + (k >> 3), x = k & 7, b = bh >> 3, h = bh & 7;
    const int qcol = (MODE == 0 ? 0 : 3072) + h * D;
    const bf16* Qb = QKV + (size_t)b * 4096 * LDQ + qcol;
    bf16* Ob = O8 ? (bf16*)((char*)O + ((size_t)b * 4096 * LDO + (MODE == 0 ? 0 : 1024) + h * D)) : O + (size_t)b * 4096 * LDO + (MODE == 0 ? 0 : 1024) + h * D;
    const bf16* KXb = KXall + (size_t)bh * 4096 * 2;
    Seam S;
    BlockRef cur{Qb, Ob, KXb, x * QB};
    attn_prime(cur, lds, S, wv);
    for (int pass = 0; pass < 2; ++pass) {
        const int qn = 15 - x;
        if (MODE == 0) attn_block<0, EARLY, O8>(cur, qn * QB, cur.Qb, lds, S, kmax + bh * 4, wv); else sb_block<EARLY, O8>(cur, qn * QB, cur.Qb, lds, S, wv);
        cur.P0 = qn * QB;
    }
}
template <int MODE, bool EARLY, bool O8>
__device__ __forceinline__ void attn_one(char* lds, const bf16* QKV, const bf16* KXall, bf16* O, int bh, int x, const unsigned* kmax, const int wv) {
    const int b = bh >> 3, h = bh & 7;
    const int qcol = (MODE == 0 ? 0 : 3072) + h * D;
    const bf16* Qb = QKV + (size_t)b * 4096 * LDQ + qcol;
    bf16* Ob = O8 ? (bf16*)((char*)O + ((size_t)b * 4096 * LDO + (MODE == 0 ? 0 : 1024) + h * D)) : O + (size_t)b * 4096 * LDO + (MODE == 0 ? 0 : 1024) + h * D;
    const bf16* KXb = KXall + (size_t)bh * 4096 * 2;
    Seam S;
    BlockRef cur{Qb, Ob, KXb, x * QB};
    attn_prime(cur, lds, S, wv);
    if (MODE == 0) attn_block<0, EARLY, O8>(cur, x * QB, cur.Qb, lds, S, kmax + bh * 4, wv); else sb_block<EARLY, O8>(cur, x * QB, cur.Qb, lds, S, wv);
}
template <bool FEARLY, bool SEARLY, bool O8>
__device__ __forceinline__ BlockRef queue_ref(const bf16* QKV, const bf16* KXall, bf16* O, int it) {
    const int bh = it & 31, x = 15 - ((it & 511) >> 5), md = it >> 9, b = bh >> 3, h = bh & 7;
    const size_t ocol = (size_t)b * 4096 * LDO + (md == 0 ? 0 : 1024) + h * D;
    BlockRef r; r.Qb = QKV + (size_t)b * 4096 * LDQ + (md == 0 ? 0 : 3072) + h * D; r.Ob = O8 ? (bf16*)((char*)O + ocol) : O + ocol; r.KX = KXall + (size_t)bh * 4096 * 2; r.P0 = x * QB; return r;
}
template <bool FEARLY, bool SEARLY, bool O8>
__device__ __forceinline__ void attn_queue(char* lds, const bf16* QKV, const bf16* KXall, bf16* O, const unsigned* kmax, unsigned* ctr, volatile unsigned* slot, const int wv, const bool t0) {
    __syncthreads();
    if (t0) *slot = __hip_atomic_fetch_add(ctr, 1u, __ATOMIC_RELAXED, __HIP_MEMORY_SCOPE_AGENT);
    __syncthreads();
    int it = __builtin_amdgcn_readfirstlane((int)*slot);
    if (it >= 1024) return;
    Seam S; BlockRef cur = queue_ref<FEARLY, SEARLY, O8>(QKV, KXall, O, it);
    attn_prime(cur, lds, S, wv);
    for (;;) {
        __syncthreads();
        if (t0) *slot = __hip_atomic_fetch_add(ctr, 1u, __ATOMIC_RELAXED, __HIP_MEMORY_SCOPE_AGENT);
        __syncthreads();
        const int nx = __builtin_amdgcn_readfirstlane((int)*slot); const bool has = nx < 1024;
        BlockRef nr = cur; if (has) nr = queue_ref<FEARLY, SEARLY, O8>(QKV, KXall, O, nx);
        if (it < 512) attn_block<0, FEARLY, O8>(cur, nr.P0, nr.Qb, lds, S, kmax + (it & 31) * 4, wv); else sb_block<SEARLY, O8>(cur, nr.P0, nr.Qb, lds, S, wv);
        if (!has) break;
        it = nx; cur = nr;
    }
}
}
__device__ __forceinline__ float wave_sum_l(float v, int lane) {
#pragma unroll
    for (int o = 1; o < 64; o <<= 1) v += lx(v, o, lane);
    return v;
}
#define wave_sum(v) wave_sum_l((v), lane)
__device__ __forceinline__ float wave_max_l(float v, int lane) {
#pragma unroll
    for (int o = 1; o < 64; o <<= 1) v = fmaxf(v, lx(v, o, lane));
    return v;
}
#define wave_max(v) wave_max_l((v), lane)
__device__ __forceinline__ float bf2f(unsigned short b) { return __uint_as_float((unsigned)b << 16); }
__device__ __forceinline__ float bflo(unsigned w) { return __uint_as_float(w << 16); }
__device__ __forceinline__ float bfhi(unsigned w) { return __uint_as_float(w & 0xffff0000u); }

__device__ __forceinline__ void tr_item(const float* W, int ldw, int K, bf16* WT, int kb, int src_col, int dst_row, float scale, LAS float* scr, int lane) {
    const int k0 = 64 * kb;
#pragma unroll
    for (int i = 0; i < 8; ++i) { const int kk = 8 * i + (lane >> 3), c4 = (lane & 7) * 4; const f32x4 w = *(const f32x4*)(W + (size_t)(k0 + kk) * ldw + src_col + c4);
        LAS float* d = scr + kk * 33 + c4; d[0] = w.x; d[1] = w.y; d[2] = w.z; d[3] = w.w; }
    LDS_WAIT(); asm volatile("" ::: "memory");
    const int c = lane & 7;
#pragma unroll
    for (int j = 0; j < 4; ++j) { const int n = (lane >> 3) + 8 * j; const LAS float* s = scr + (8 * c) * 33 + n;
        v4u o; o.x = pk2(s[0 * 33] * scale, s[1 * 33] * scale); o.y = pk2(s[2 * 33] * scale, s[3 * 33] * scale); o.z = pk2(s[4 * 33] * scale, s[5 * 33] * scale); o.w = pk2(s[6 * 33] * scale, s[7 * 33] * scale);
        *(GAS v4u*)(WT + (size_t)(dst_row + n) * K + k0 + 8 * c) = o; }
    LDS_WAIT(); asm volatile("" ::: "memory");
}
__device__ __forceinline__ void tr_item8(const float* W, int ldw, int K, unsigned char* WT, int kb, int src_col, int dst_row, float scale, LAS float* scr, int lane) {
    const int k0 = 64 * kb;
#pragma unroll
    for (int i = 0; i < 8; ++i) { const int kk = 8 * i + (lane >> 3), c4 = (lane & 7) * 4; const f32x4 w = *(const f32x4*)(W + (size_t)(k0 + kk) * ldw + src_col + c4);
        LAS float* d = scr + kk * 33 + c4; d[0] = w.x; d[1] = w.y; d[2] = w.z; d[3] = w.w; }
    LDS_WAIT(); asm volatile("" ::: "memory");
    const int c = lane & 3;
#pragma unroll
    for (int j = 0; j < 2; ++j) { const int n = (lane >> 2) + 16 * j; const LAS float* s = scr + (16 * c) * 33 + n;
        v4u o; o.x = pg8::pack_fp8x4(s[0 * 33] * scale, s[1 * 33] * scale, s[2 * 33] * scale, s[3 * 33] * scale); o.y = pg8::pack_fp8x4(s[4 * 33] * scale, s[5 * 33] * scale, s[6 * 33] * scale, s[7 * 33] * scale);
        o.z = pg8::pack_fp8x4(s[8 * 33] * scale, s[9 * 33] * scale, s[10 * 33] * scale, s[11 * 33] * scale); o.w = pg8::pack_fp8x4(s[12 * 33] * scale, s[13 * 33] * scale, s[14 * 33] * scale, s[15 * 33] * scale);
        *(GAS v4u*)(WT + (size_t)(dst_row + n) * K + k0 + 16 * c) = o; }
    LDS_WAIT(); asm volatile("" ::: "memory");
}
__device__ __forceinline__ unsigned pack_i8x4(float a, float b, float c, float d) {
    const int qa = (int)fminf(fmaxf(rintf(a), -127.f), 127.f), qb = (int)fminf(fmaxf(rintf(b), -127.f), 127.f), qc = (int)fminf(fmaxf(rintf(c), -127.f), 127.f), qd = (int)fminf(fmaxf(rintf(d), -127.f), 127.f);
    return (unsigned)(qa & 255) | ((unsigned)(qb & 255) << 8) | ((unsigned)(qc & 255) << 16) | ((unsigned)(qd & 255) << 24);
}
struct Args { const float* in[17]; float* out; unsigned char* ws; int ph_lo, ph_hi, li, pad; };
typedef const __attribute__((address_space(4))) Args* kargs_t;
__device__ __forceinline__ kargs_t kargs() { unsigned long long p = (unsigned long long)__builtin_amdgcn_kernarg_segment_ptr(); asm volatile("" : "+s"(p)); return (kargs_t)p; }
enum { I_X = 0, I_MIXN, I_FFNN, I_FINN, I_WINATT, I_BFORGET, I_WOUTATT, I_WINCONV, I_CONVW, I_WOUTCONV, I_WGD, I_WUD, I_WDD, I_WROUTER, I_WGM, I_WUM, I_WDM };
constexpr int IT_AIN = 8 * 192, IT_SQ = 8 * 64, IT_FF = 8 * 176, IT_DN = 22 * 64, IT_ME = 8 * 88, IT_MD = 11 * 64;
constexpr int IT_PER_J = 2 * IT_AIN + 2 * IT_SQ + 2 * IT_FF + IT_DN + NE * (2 * IT_ME + IT_MD);
__device__ __forceinline__ int cin_row(int nb) { const int seg = nb >> 6, c = 32 * (nb & 63); return seg == 0 ? c : 2048 + (c >> 7) * 256 + (seg == 2 ? 128 : 0) + (c & 127); }
template <int FMT>
__device__ __forceinline__ void tr_item4(const float* W, int ldw, int K, unsigned char* WT, int kb4, int src_col, int dst_row, float scale, LAS float* scr, int lane) {
    f32x4 w[4][8]; const int c4 = (lane & 7) * 4, k0 = 256 * kb4;
    const char* Wb = (const char*)(W + (size_t)k0 * ldw + src_col);
    const unsigned voff = (unsigned)((lane >> 3) * ldw + c4) * 4u;
#pragma unroll
    for (int q = 0; q < 4; ++q)
#pragma unroll
        for (int i = 0; i < 8; ++i) { const char* Wu = Wb + (size_t)((64 * q + 8 * i) * ldw) * 4; w[q][i] = *(const f32x4*)(Wu + (size_t)voff); }
#pragma unroll
    for (int q = 0; q < 4; ++q) {
#pragma unroll
        for (int i = 0; i < 8; ++i) { const int kk = 8 * i + (lane >> 3); LAS float* d = scr + kk * 33 + c4; d[0] = w[q][i].x; d[1] = w[q][i].y; d[2] = w[q][i].z; d[3] = w[q][i].w; }
        LDS_WAIT(); asm volatile("" ::: "memory");
        if (FMT == 0) { const int c = lane & 7;
#pragma unroll
            for (int j = 0; j < 4; ++j) { const int n = (lane >> 3) + 8 * j; const LAS float* s = scr + (8 * c) * 33 + n;
                v4u o; o.x = pk2(s[0 * 33] * scale, s[1 * 33] * scale); o.y = pk2(s[2 * 33] * scale, s[3 * 33] * scale); o.z = pk2(s[4 * 33] * scale, s[5 * 33] * scale); o.w = pk2(s[6 * 33] * scale, s[7 * 33] * scale);
                *(GAS v4u*)((bf16*)WT + (size_t)(dst_row + n) * K + k0 + 64 * q + 8 * c) = o; } }
        else { const int c = lane & 3;
#pragma unroll
            for (int j = 0; j < 2; ++j) { const int n = (lane >> 2) + 16 * j; const LAS float* s = scr + (16 * c) * 33 + n;
                v4u o; o.x = pg8::pack_fp8x4(s[0 * 33] * scale, s[1 * 33] * scale, s[2 * 33] * scale, s[3 * 33] * scale); o.y = pg8::pack_fp8x4(s[4 * 33] * scale, s[5 * 33] * scale, s[6 * 33] * scale, s[7 * 33] * scale);
                o.z = pg8::pack_fp8x4(s[8 * 33] * scale, s[9 * 33] * scale, s[10 * 33] * scale, s[11 * 33] * scale); o.w = pg8::pack_fp8x4(s[12 * 33] * scale, s[13 * 33] * scale, s[14 * 33] * scale, s[15 * 33] * scale);
                *(GAS v4u*)(WT + (size_t)(dst_row + n) * K + k0 + 64 * q + 16 * c) = o; } }
        LDS_WAIT(); asm volatile("" ::: "memory");
    }
}
__device__ __forceinline__ void p0_item(int it, LAS float* scr, int lane) {
    const kargs_t KA = kargs(); unsigned char* ws = KA->ws;
    const int j = it / IT_PER_J; int r = it - j * IT_PER_J;
    const float* W = nullptr; unsigned char* WT = nullptr; int ldw = 0, K = DM, kb4 = 0, src_col = 0, dst_row = 0, fmt = -1; float scale = 1.0f;
    if (r < IT_AIN) { kb4 = r / 192; const int nb = r % 192; const bool isq = (nb < 32) || (nb >= 96 && nb < 128);
        fmt = I8_AIN_LP(j) ? -1 : 0; W = KA->in[I_WINATT] + (size_t)j * DM * ATT_SRC_LD; ldw = ATT_SRC_LD; WT = ws + WS_AIN + j * SZ_AIN; src_col = 32 * nb + (nb >= 96 ? 8 : 0); dst_row = 32 * nb; scale = isq ? QSCALE : 1.0f; }
    else if ((r -= IT_AIN) < IT_SQ) { kb4 = r / 64; const int nb = r % 64;
        fmt = AOUT8_LP(j) ? 1 : 0; W = KA->in[I_WOUTATT] + (size_t)j * DM * DM; ldw = DM; WT = ws + WS_AOUT + j * SZ_SQ; src_col = 32 * nb; dst_row = 32 * nb; scale = AOUT8_LP(j) ? 64.0f : 1.0f; }
    else if ((r -= IT_SQ) < IT_AIN) { kb4 = r / 192; const int nb = r % 192;
        fmt = I8_CIN_LP(j) ? -1 : 0; W = KA->in[I_WINCONV] + (size_t)j * DM * 3 * DM; ldw = 3 * DM; WT = ws + WS_CIN + j * SZ_AIN; src_col = 32 * nb; dst_row = cin_row(nb); }
    else if ((r -= IT_AIN) < IT_SQ) { kb4 = r / 64; const int nb = r % 64;
        fmt = COUT8_LP(j) ? 1 : 0; W = KA->in[I_WOUTCONV] + (size_t)j * DM * DM; ldw = DM; WT = ws + WS_COUT + j * SZ_SQ; src_col = 32 * nb; dst_row = 32 * nb; scale = COUT8_LP(j) ? 64.0f : 1.0f; }
    else if ((r -= IT_SQ) < 2 * IT_FF) { const int up = r >= IT_FF; if (up) r -= IT_FF; kb4 = r / 176; const int nb = r % 176, n0 = 32 * nb;
        fmt = I8_GU_LP(j) ? -1 : (FFN_GU8_LP(j) ? 1 : 0); W = (up ? KA->in[I_WUD] : KA->in[I_WGD]) + (size_t)j * DM * FF; ldw = FF; WT = ws + WS_GU + j * SZ_GU; src_col = n0; dst_row = (n0 >> 7) * 256 + (up ? 128 : 0) + (n0 & 127); scale = FFN_GU8_LP(j) ? 64.0f : 1.0f; }
    else if ((r -= 2 * IT_FF) < IT_DN) { kb4 = r / 64; const int nb = r % 64;
        fmt = FFN_DN8_LP(j) ? 1 : 0; W = KA->in[I_WDD] + (size_t)j * FF * DM; ldw = DM; K = FF; WT = ws + WS_DN + j * SZ_DN; src_col = 32 * nb; dst_row = 32 * nb; scale = FFN_DN8_LP(j) ? 64.0f : 1.0f; }
    else { r -= IT_DN; const int e = r / (2 * IT_ME + IT_MD); r -= e * (2 * IT_ME + IT_MD); const int je = j * NE + e;
        if (r < 2 * IT_ME) { const int up = r >= IT_ME; if (up) r -= IT_ME; kb4 = r / 88; const int nb = r % 88, n0 = 32 * nb;
            fmt = I8_MGU_LP(j) ? -1 : (MOE_FP8_LP(j) ? 1 : 0); W = (up ? KA->in[I_WUM] : KA->in[I_WGM]) + (size_t)je * DM * FFE; ldw = FFE; WT = ws + WS_MGU + je * SZ_MGU; src_col = n0; dst_row = (n0 >> 7) * 256 + (up ? 128 : 0) + (n0 & 127); scale = MOE_FP8_LP(j) ? 64.0f : 1.0f; }
        else { r -= 2 * IT_ME; kb4 = r / 64; const int nb = r % 64;
            fmt = MOE_FP8_LP(j) ? 1 : 0; W = KA->in[I_WDM] + (size_t)je * FFE * DM; ldw = DM; K = FFE; WT = ws + WS_MDN + je * SZ_MDN; src_col = 32 * nb; dst_row = 32 * nb; scale = MOE_FP8_LP(j) ? 64.0f : 1.0f; } }
    if (fmt == 0) tr_item4<0>(W, ldw, K, WT, kb4, src_col, dst_row, scale, scr, lane);
    else if (fmt == 1) tr_item4<1>(W, ldw, K, WT, kb4, src_col, dst_row, scale, scr, lane);
}
constexpr int I8_PER_J = 192 + 192 + 352 + NE * 176;
struct I8D { const float* W; unsigned char* WT; float* wsc; int ldw, src_col, dst_row; float post; bool act; };
__device__ __forceinline__ I8D p0_i8_decode(int it) {
    const kargs_t KA = kargs(); unsigned char* ws = KA->ws; float* wsc = (float*)(ws + WS_WSC);
    I8D d; d.post = 1.0f; d.act = false; d.W = nullptr; d.WT = nullptr; d.wsc = wsc; d.ldw = 0; d.src_col = 0; d.dst_row = 0;
    if (it >= 2 * I8_PER_J) return d;
    const int j = it / I8_PER_J; int r = it - j * I8_PER_J;
    if (r < 192) { const int nb = r; const bool isq = (nb < 32) || (nb >= 96 && nb < 128);
        d.act = I8_AIN_LP(j); d.W = KA->in[I_WINATT] + (size_t)j * DM * ATT_SRC_LD; d.ldw = ATT_SRC_LD; d.WT = ws + WS_AIN + j * SZ_AIN; d.wsc = wsc + WSC_AIN + j * 6144; d.src_col = 32 * nb + (nb >= 96 ? 8 : 0); d.dst_row = 32 * nb; d.post = isq ? QSCALE : 1.0f; }
    else if (r < 384) { const int nb = r - 192;
        d.act = I8_CIN_LP(j); d.W = KA->in[I_WINCONV] + (size_t)j * DM * 3 * DM; d.ldw = 3 * DM; d.WT = ws + WS_CIN + j * SZ_AIN; d.wsc = wsc + WSC_CIN + j * 6144; d.src_col = 32 * nb; d.dst_row = cin_row(nb); }
    else if (r < 736) { r -= 384; const int up = r >= 176; if (up) r -= 176; const int n0 = 32 * r;
        d.act = I8_GU_LP(j); d.W = (up ? KA->in[I_WUD] : KA->in[I_WGD]) + (size_t)j * DM * FF; d.ldw = FF; d.WT = ws + WS_GU + j * SZ_GU; d.wsc = wsc + WSC_GU + j * 11264; d.src_col = n0; d.dst_row = (n0 >> 7) * 256 + (up ? 128 : 0) + (n0 & 127); }
    else { r -= 736; const int e = r / 176; r -= e * 176; const int je = j * NE + e; const int up = r >= 88; if (up) r -= 88; const int n0 = 32 * r;
        d.act = I8_MGU_LP(j); d.W = (up ? KA->in[I_WUM] : KA->in[I_WGM]) + (size_t)je * DM * FFE; d.ldw = FFE; d.WT = ws + WS_MGU + je * SZ_MGU; d.wsc = wsc + WSC_MGU + je * 5632; d.src_col = n0; d.dst_row = (n0 >> 7) * 256 + (up ? 128 : 0) + (n0 & 127); }
    return d;
}
__device__ __forceinline__ void p0_i8_stream(LAS float* scr, LAS float* smax, int wave, int lane, int G) {
    const int total = 2 * I8_PER_J;
    int it = blockIdx.x; I8D cur = p0_i8_decode(it);
    while (it < total && !cur.act) { it += G; cur = p0_i8_decode(it); }
    if (it >= total) return;
    f32x4 w[4][8]; const int c4 = (lane & 7) * 4;
#define I8_LOADQ(D_, q_) do { const unsigned vo_ = (unsigned)((64 * wave + (lane >> 3)) * (D_).ldw + (D_).src_col + c4) * 4u; \
        _Pragma("unroll") for (int i = 0; i < 8; ++i) { const char* Wu = (const char*)(D_).W + (size_t)((512 * (q_) + 8 * i) * (D_).ldw) * 4; w[q_][i] = *(const f32x4*)(Wu + (size_t)vo_); } } while (0)
    I8_LOADQ(cur, 0); I8_LOADQ(cur, 1); I8_LOADQ(cur, 2); I8_LOADQ(cur, 3);
    for (;;) {
        int nit = it + G; I8D nxt = p0_i8_decode(nit);
        while (nit < total && !nxt.act) { nit += G; nxt = p0_i8_decode(nit); }
        const bool has = nit < total;
        float cm0 = 0.f, cm1 = 0.f, cm2 = 0.f, cm3 = 0.f;
#pragma unroll
        for (int q = 0; q < 4; ++q)
#pragma unroll
            for (int i = 0; i < 8; ++i) { cm0 = fmaxf(cm0, fabsf(w[q][i].x)); cm1 = fmaxf(cm1, fabsf(w[q][i].y)); cm2 = fmaxf(cm2, fabsf(w[q][i].z)); cm3 = fmaxf(cm3, fabsf(w[q][i].w)); }
#pragma unroll
        for (int o = 8; o < 64; o <<= 1) { cm0 = fmaxf(cm0, lx(cm0, o, lane)); cm1 = fmaxf(cm1, lx(cm1, o, lane)); cm2 = fmaxf(cm2, lx(cm2, o, lane)); cm3 = fmaxf(cm3, lx(cm3, o, lane)); }
        if (lane < 8) { LAS float* d = smax + wave * 32 + c4; d[0] = cm0; d[1] = cm1; d[2] = cm2; d[3] = cm3; }
        __syncthreads();
        float mx0 = 0.f, mx1 = 0.f, mx2 = 0.f, mx3 = 0.f;
#pragma unroll
        for (int v = 0; v < 8; ++v) { const LAS float* s = smax + v * 32 + c4; mx0 = fmaxf(mx0, s[0]); mx1 = fmaxf(mx1, s[1]); mx2 = fmaxf(mx2, s[2]); mx3 = fmaxf(mx3, s[3]); }
        if (wave == 0 && lane < 8) { const float ps = cur.post / 127.0f; f32x4 o; o.x = mx0 * ps; o.y = mx1 * ps; o.z = mx2 * ps; o.w = mx3 * ps; *(f32x4*)(cur.wsc + cur.dst_row + c4) = o; }
        const float i0 = mx0 > 0.f ? 127.0f / mx0 : 0.f, i1 = mx1 > 0.f ? 127.0f / mx1 : 0.f, i2 = mx2 > 0.f ? 127.0f / mx2 : 0.f, i3 = mx3 > 0.f ? 127.0f / mx3 : 0.f;
#pragma unroll
        for (int q = 0; q < 4; ++q) { const int k0 = 64 * (wave + 8 * q);
#pragma unroll
            for (int i = 0; i < 8; ++i) { const int kk = 8 * i + (lane >> 3); LAS float* d = scr + kk * 33 + c4; d[0] = w[q][i].x * i0; d[1] = w[q][i].y * i1; d[2] = w[q][i].z * i2; d[3] = w[q][i].w * i3; }
            if (has) I8_LOADQ(nxt, q);
            LDS_WAIT(); asm volatile("" ::: "memory");
            const int c = lane & 3;
#pragma unroll
            for (int jj = 0; jj < 2; ++jj) { const int n = (lane >> 2) + 16 * jj; const LAS float* s = scr + (16 * c) * 33 + n;
                v4u o; o.x = pack_i8x4(s[0 * 33], s[1 * 33], s[2 * 33], s[3 * 33]); o.y = pack_i8x4(s[4 * 33], s[5 * 33], s[6 * 33], s[7 * 33]);
                o.z = pack_i8x4(s[8 * 33], s[9 * 33], s[10 * 33], s[11 * 33]); o.w = pack_i8x4(s[12 * 33], s[13 * 33], s[14 * 33], s[15 * 33]);
                *(GAS v4u*)(cur.WT + (size_t)(cur.dst_row + n) * DM + k0 + 16 * c) = o; }
            LDS_WAIT(); asm volatile("" ::: "memory");
        }
        __syncthreads();
        if (!has) break;
        cur = nxt; it = nit;
    }
#undef I8_LOADQ
}

template <int MODE, bool COMBINE, int OUTQ = 0>
__device__ __forceinline__ void norm_phase(LAS unsigned char* lds, int wave, int lane, int tid, const float* xin, float* xout, const bf16* Y, const float* gain, bf16* H, float* fout,
                                           const float* W8src, int w8ld, const float* bias8, float* ex_out, unsigned* mcnt, int* mlist, float* mgate, float* sx = nullptr, float* msc = nullptr) {
    const int G = gridDim.x;
    LAS float* W8t = (LAS float*)lds;
    LAS int* rt_e = (LAS int*)(lds + 65536); LAS float* rt_g = (LAS float*)(lds + 65536 + 256); LAS float* rt_s = (LAS float*)(lds + 65536 + 1024);
    if (MODE == 1 || MODE == 4) {
        for (int k = tid; k < DM; k += NWAVES * 64) { const f32x4 a = *(const f32x4*)(W8src + (size_t)k * w8ld), b = *(const f32x4*)(W8src + (size_t)k * w8ld + 4);
            W8t[0 * DM + k] = a.x; W8t[1 * DM + k] = a.y; W8t[2 * DM + k] = a.z; W8t[3 * DM + k] = a.w; W8t[4 * DM + k] = b.x; W8t[5 * DM + k] = b.y; W8t[6 * DM + k] = b.z; W8t[7 * DM + k] = b.w; }
        __syncthreads();
    }
    f32x4 gv[8];
#pragma unroll
    for (int j = 0; j < 8; ++j) gv[j] = ((const f32x4*)gain)[lane + 64 * j];
    const int npass = (MODE == 4) ? (M / 64 + G - 1) / G : (M + G * NWAVES - 1) / (G * NWAVES);
    constexpr int RPP = (MODE == 4) ? 8 : 1;
#define NROW(it_) ((MODE == 4) ? (blockIdx.x + ((it_) >> 3) * G) * 64 + wave * 8 + ((it_) & 7) : (blockIdx.x * NWAVES + wave) + (it_) * (G * NWAVES))
#define NROW_OK(it_) ((it_) < npass * RPP && NROW(it_) < M)
    f32x4 vn[8]; uint2 yn0[COMBINE ? 8 : 1], yn1[COMBINE ? 8 : 1];
    if (NROW_OK(0)) { const int r0 = NROW(0); const f32x4* xr = (const f32x4*)(xin + (size_t)r0 * DM) + lane;
#pragma unroll
        for (int j = 0; j < 8; ++j) vn[j] = xr[64 * j];
        if (COMBINE) { const uint2* y0 = (const uint2*)(Y + (size_t)(2 * r0) * DM) + lane; const uint2* y1 = (const uint2*)(Y + (size_t)(2 * r0 + 1) * DM) + lane;
#pragma unroll
            for (int j = 0; j < 8; ++j) { yn0[j] = y0[64 * j]; yn1[j] = y1[64 * j]; } } }
#pragma unroll 1
    for (int it = 0; it < npass * RPP; ++it) {
        const int ps = it / RPP, i = it % RPP; (void)ps;
        const int chunk = blockIdx.x + ps * G;
        {
            const int row = NROW(it);
            if (row < M) {
                f32x4 v[8]; float s = 0.f; uint2 ya[COMBINE ? 8 : 1], yb[COMBINE ? 8 : 1];
#pragma unroll
                for (int j = 0; j < 8; ++j) v[j] = vn[j];
                if (COMBINE) {
#pragma unroll
                    for (int j = 0; j < 8; ++j) { ya[j] = yn0[j]; yb[j] = yn1[j]; } }
                if (NROW_OK(it + 1)) { const int r1 = NROW(it + 1); const f32x4* xr = (const f32x4*)(xin + (size_t)r1 * DM) + lane;
#pragma unroll
                    for (int j = 0; j < 8; ++j) vn[j] = xr[64 * j];
                    if (COMBINE) { const uint2* y0 = (const uint2*)(Y + (size_t)(2 * r1) * DM) + lane; const uint2* y1 = (const uint2*)(Y + (size_t)(2 * r1 + 1) * DM) + lane;
#pragma unroll
                        for (int j = 0; j < 8; ++j) { yn0[j] = y0[64 * j]; yn1[j] = y1[64 * j]; } } }
                if (COMBINE) {
#pragma unroll
                    for (int j = 0; j < 8; ++j) { const uint2 a = ya[j], b = yb[j];
                        v[j].x += bflo(a.x) + bflo(b.x); v[j].y += bfhi(a.x) + bfhi(b.x); v[j].z += bflo(a.y) + bflo(b.y); v[j].w += bfhi(a.y) + bfhi(b.y); }
                    if (MODE != 3) { f32x4* xo = (f32x4*)(xout + (size_t)row * DM) + lane;
#pragma unroll
                        for (int j = 0; j < 8; ++j) xo[64 * j] = v[j]; }
                }
#pragma unroll
                for (int j = 0; j < 8; ++j) s += (v[j].x * v[j].x + v[j].y * v[j].y) + (v[j].z * v[j].z + v[j].w * v[j].w);
                const float inv = __builtin_amdgcn_rsqf(wave_sum(s) * (1.0f / DM) + RMS_EPS);
#pragma unroll
                for (int j = 0; j < 8; ++j) v[j] = (v[j] * inv) * gv[j];
                if (MODE != 3 && OUTQ == 2) { unsigned* o4 = (unsigned*)((unsigned char*)H + (size_t)row * DM) + lane;
                    float am = 0.f;
#pragma unroll
                    for (int j = 0; j < 8; ++j) am = fmaxf(am, fmaxf(fmaxf(fabsf(v[j].x), fabsf(v[j].y)), fmaxf(fabsf(v[j].z), fabsf(v[j].w))));
                    am = wave_max(am); const float qi = am > 0.f ? 127.0f / am : 0.f;
#pragma unroll
                    for (int j = 0; j < 8; ++j) o4[64 * j] = pack_i8x4(v[j].x * qi, v[j].y * qi, v[j].z * qi, v[j].w * qi);
                    if (lane == 0) { if (MODE == 4) rt_s[wave * 8 + i] = am * (1.0f / 127.0f); else sx[row] = am * (1.0f / 127.0f); } }
                else if (MODE != 3 && OUTQ == 1) { unsigned* o4 = (unsigned*)((unsigned char*)H + (size_t)row * DM) + lane;
#pragma unroll
                    for (int j = 0; j < 8; ++j) o4[64 * j] = pg8::pack_fp8x4(v[j].x, v[j].y, v[j].z, v[j].w); }
                else if (MODE != 3) { unsigned long long* o8 = (unsigned long long*)(H + (size_t)row * DM) + lane;
#pragma unroll
                    for (int j = 0; j < 8; ++j) o8[64 * j] = (unsigned long long)pk2(v[j].x, v[j].y) | ((unsigned long long)pk2(v[j].z, v[j].w) << 32); }
                else { f32x4* o = (f32x4*)(fout + (size_t)row * DM) + lane;
#pragma unroll
                    for (int j = 0; j < 8; ++j) o[64 * j] = v[j]; }
                if (MODE == 1 || MODE == 4) {
                    float a8[8];
#pragma unroll
                    for (int c = 0; c < 8; ++c) a8[c] = 0.f;
#pragma unroll
                    for (int j = 0; j < 8; ++j) {
#pragma unroll
                        for (int c = 0; c < 8; ++c) { const f32x4 w = *(const LAS f32x4*)(W8t + c * DM + 4 * (lane + 64 * j)); a8[c] += (v[j].x * w.x + v[j].y * w.y) + (v[j].z * w.z + v[j].w * w.w); } }
                    const bool b5 = (lane & 32) != 0, b4 = (lane & 16) != 0, b3 = (lane & 8) != 0;
                    float r4[4], r2[2];
#pragma unroll
                    for (int k = 0; k < 4; ++k) { const float mine = b5 ? a8[4 + k] : a8[k], send = b5 ? a8[k] : a8[4 + k]; r4[k] = mine + lx(send, 32, lane); }
#pragma unroll
                    for (int k = 0; k < 2; ++k) { const float mine = b4 ? r4[2 + k] : r4[k], send = b4 ? r4[k] : r4[2 + k]; r2[k] = mine + lx(send, 16, lane); }
                    float val; { const float mine = b3 ? r2[1] : r2[0], send = b3 ? r2[0] : r2[1]; val = mine + lx(send, 8, lane); }
                    val += lx(val, 4, lane); val += lx(val, 2, lane); val += lx(val, 1, lane);
                    if (MODE == 1) {
                        if ((lane & 7) == 0) { const int hh = lane >> 3; const float t = val + bias8[hh]; const float t2 = t * LOG2E; ex_out[(size_t)((row >> 12) * 8 + hh) * SEQ + (row & (SEQ - 1))] = -(fmaxf(-t2, 0.f) + __builtin_amdgcn_logf(1.0f + __builtin_amdgcn_exp2f(-fabsf(t2))));     }
                    } else {
                        float p[8];
#pragma unroll
                        for (int c = 0; c < 8; ++c) p[c] = __uint_as_float((unsigned)__builtin_amdgcn_readlane((int)__float_as_uint(val), 8 * c));
                        int e1 = 0; float v1 = p[0];
#pragma unroll
                        for (int c = 1; c < 8; ++c) if (p[c] > v1) { v1 = p[c]; e1 = c; }
                        int e2 = -1; float v2 = -__builtin_inff();
#pragma unroll
                        for (int c = 0; c < 8; ++c) if (c != e1 && p[c] > v2) { v2 = p[c]; e2 = c; }
                        const float t = __builtin_amdgcn_exp2f((v2 - v1) * LOG2E), g1 = 1.0f / (1.0f + t), g2 = t / (1.0f + t);
                        if (lane == 0) { const int rl = wave * 8 + i; rt_e[rl] = e1 | (e2 << 8); rt_g[2 * rl] = g1; rt_g[2 * rl + 1] = g2; }
                    }
                }
            }
        }
        if (MODE == 4 && i == RPP - 1) {
            __syncthreads();
            if (wave == 0 && chunk < M / 64) {
                const int ee = rt_e[lane], e1 = ee & 255, e2 = ee >> 8; const float g1 = rt_g[2 * lane], g2 = rt_g[2 * lane + 1];
                const unsigned long long lt = (1ull << lane) - 1ull;
                int cA[8], cB[8], tot = 0, pA = 0, pB = 0;
#pragma unroll
                for (int e = 0; e < 8; ++e) { const unsigned long long bA = __ballot(e1 == e), bB = __ballot(e2 == e); cA[e] = __popcll(bA); cB[e] = __popcll(bB);
                    if (e1 == e) pA = __popcll(bA & lt); if (e2 == e) pB = cA[e] + __popcll(bB & lt); tot = (lane == e) ? cA[e] + cB[e] : tot; }
                unsigned basev = 0; if (lane < 8) basev = __hip_atomic_fetch_add(mcnt + lane, (unsigned)tot, __ATOMIC_RELAXED, __HIP_MEMORY_SCOPE_AGENT);
                int b1 = 0, b2 = 0;
#pragma unroll
                for (int e = 0; e < 8; ++e) { const int be = __builtin_amdgcn_readlane((int)basev, e); if (e1 == e) b1 = be; if (e2 == e) b2 = be; }
                const int tok = chunk * 64 + lane;
                mlist[e1 * 16384 + b1 + pA] = tok * 2; mgate[e1 * 16384 + b1 + pA] = g1;
                mlist[e2 * 16384 + b2 + pB] = tok * 2 + 1; mgate[e2 * 16384 + b2 + pB] = g2;
                if (OUTQ == 2) { const float s = rt_s[lane]; msc[e1 * 16384 + b1 + pA] = s; msc[e2 * 16384 + b2 + pB] = s; }
            }
            __syncthreads();
        }
    }
#undef NROW
#undef NROW_OK
}

__device__ __forceinline__ void cumsum_seq(const float* logf, float* c2, int bh, int lane) {
    const f32x4* lf = (const f32x4*)(logf + (size_t)bh * SEQ + 64 * lane);
    f32x4 v[16]; float loc = 0.f;
#pragma unroll
    for (int i = 0; i < 16; ++i) { v[i] = lf[i]; loc += (v[i].x + v[i].y) + (v[i].z + v[i].w); }
    float incl = loc;
#pragma unroll
    for (int off = 1; off < 64; off <<= 1) { const float y = __uint_as_float((unsigned)__builtin_amdgcn_ds_bpermute(((lane - off) & 63) << 2, (int)__float_as_uint(incl))); if (lane >= off) incl += y; }
    float run = incl - loc;
    f32x4* co = (f32x4*)(c2 + (size_t)bh * SEQ + 64 * lane);
#pragma unroll
    for (int i = 0; i < 16; ++i) { f32x4 o; run += v[i].x; o.x = run; run += v[i].y; o.y = run; run += v[i].z; o.z = run; run += v[i].w; o.w = run; co[i] = o; }
}

__device__ __forceinline__ void unpack8(const v4u w, float (&f)[8]) { f[0] = bflo(w.x); f[1] = bfhi(w.x); f[2] = bflo(w.y); f[3] = bfhi(w.y); f[4] = bflo(w.z); f[5] = bfhi(w.z); f[6] = bflo(w.w); f[7] = bfhi(w.w); }
template <bool O8>
__device__ __forceinline__ void conv_phase(const bf16* P2, const float* cw, bf16* Y, int gt, int NGT) {
    constexpr int LDP = 4096;
    for (int item = gt; item < (M / 16) * 256; item += NGT) {
        const int cg = item & 255, ci = item >> 8, c0 = cg * 8, t0 = ci * 16;
        float w0[8], w1[8], w2[8];
#pragma unroll
        for (int i = 0; i < 8; ++i) { w0[i] = cw[c0 + i]; w1[i] = cw[DM + c0 + i]; w2[i] = cw[2 * DM + c0 + i]; }
        float gm2[8], gm1[8];
#pragma unroll
        for (int i = 0; i < 8; ++i) { gm2[i] = 0.f; gm1[i] = 0.f; }
        if ((t0 & (SEQ - 1)) != 0) { unpack8(*(const v4u*)(P2 + (size_t)(t0 - 2) * LDP + DM + c0), gm2); unpack8(*(const v4u*)(P2 + (size_t)(t0 - 1) * LDP + DM + c0), gm1); }
        v4u rb[16], rg[16];
#pragma unroll
        for (int r = 0; r < 16; ++r) { rb[r] = *(const v4u*)(P2 + (size_t)(t0 + r) * LDP + c0); rg[r] = *(const v4u*)(P2 + (size_t)(t0 + r) * LDP + DM + c0); }
        asm volatile("" ::: "memory");
#pragma unroll
        for (int r = 0; r < 16; ++r) {
            const size_t row = (size_t)(t0 + r);
            float gb[8], g[8], y[8];
            unpack8(rb[r], gb); unpack8(rg[r], g);
#pragma unroll
            for (int i = 0; i < 8; ++i) { y[i] = gb[i] * (w0[i] * gm2[i] + w1[i] * gm1[i] + w2[i] * g[i]); gm2[i] = gm1[i]; gm1[i] = g[i]; }
            if (O8) { uint2 o; o.x = pg8::pack_fp8x4(2.0f * y[0], 2.0f * y[1], 2.0f * y[2], 2.0f * y[3]); o.y = pg8::pack_fp8x4(2.0f * y[4], 2.0f * y[5], 2.0f * y[6], 2.0f * y[7]);
                *(uint2*)((unsigned char*)Y + row * DM + c0) = o; }
            else { v4u o; o.x = pk2(y[0], y[1]); o.y = pk2(y[2], y[3]); o.z = pk2(y[4], y[5]); o.w = pk2(y[6], y[7]);
            *(v4u*)(Y + row * DM + c0) = o; }
        }
    }
}

__device__ __forceinline__ int moe_table(LAS int* tab, const unsigned* mcnt, int tid) {
    if (tid < 64) {
        const int lane = tid, c = lane < NE ? (int)__hip_atomic_load(mcnt + (lane & 7), __ATOMIC_RELAXED, __HIP_MEMORY_SCOPE_AGENT) : 0, np = (c + 255) >> 8;
        int incl = np;
#pragma unroll
        for (int o = 1; o < 8; o <<= 1) { const int y = __builtin_amdgcn_ds_bpermute(((lane - o) & 63) << 2, incl); if (lane >= o) incl += y; }
        const int off = incl - np;
        if (lane < NE) { tab[lane] = c;
            for (int p = 0; p < np; ++p) { tab[8 + off + p] = lane; tab[160 + off + p] = p * 256; }
            if (lane == NE - 1) tab[300] = incl; }
    }
    __syncthreads();
    return __builtin_amdgcn_readfirstlane(tab[300]);
}

#define WSP(off) (kargs()->ws + (off))
__device__ __forceinline__ unsigned lds_off() { unsigned z = 0; asm volatile("" : "+s"(z)); return z; }
__global__ void __launch_bounds__(NWAVES * 64, 2) mega_fwd(Args args_unused) {
    extern __shared__ __attribute__((aligned(16))) unsigned char lds_raw[];
#define LDSP ((LAS unsigned char*)lds_raw + lds_off())
    volatile LAS unsigned* MISC = (volatile LAS unsigned*)((LAS unsigned char*)lds_raw + MISC_OFF);
#define TID_DECL int tid = wv * 64 + lane_id_asm(); asm volatile("" : "+v"(tid)); const int lane = tid & 63, wave = __builtin_amdgcn_readfirstlane(tid >> 6); const int G = gridDim.x, gw = blockIdx.x * NWAVES + wave, NGW = G * NWAVES; (void)lane; (void)gw; (void)NGW; (void)G
    const int wv = __builtin_amdgcn_readfirstlane((int)threadIdx.x >> 6);
#define T0() (wv == 0 && lane_id_asm() == 0)
    { TID_DECL;
    for (int u = tid; u < (LDS_BYTES - LDSCTL_OFF) / 4; u += NWAVES * 64) ((LAS unsigned*)((LAS unsigned char*)lds_raw + LDSCTL_OFF))[u] = 0u;
    __syncthreads(); }
    XcdBarrier bar; bar.bar = (unsigned*)(WSP(WS_CTL)) + CW_BAR + kargs()->li * XCD_BAR_WORDS; bar.x = 0; bar.st = nullptr;
    if (ONE_LAUNCH) bar = xcd_barrier_post((unsigned*)(WSP(WS_CTL)) + CW_BAR + kargs()->li * XCD_BAR_WORDS, MISC + 8, T0());
    const int G = gridDim.x;
#define GRID_BAR() do { if (ONE_LAUNCH) { XcdBarrier b_ = bar; b_.bar = (unsigned*)(WSP(WS_CTL)) + CW_BAR + kargs()->li * XCD_BAR_WORDS; xcd_barrier(b_, T0()); } } while (0)
    const int lo = kargs()->ph_lo, hi = kargs()->ph_hi;
#define IN(k) (lo <= (k) && (k) < hi)
#define BOTH(k) (IN(k) && IN((k) + 1))
#define GEMM_PHASE(EPI, Aptr, Bptr, N_, K_, Eobj) do { pg8::Gemm g{(const pg8::bf16_t*)(Aptr), (const pg8::bf16_t*)(Bptr), M, (N_), (K_)}; pg8::StaticOrder S; S.init(M, (N_), G, (int)blockIdx.x); \
        pg8::gemm_phase<EPI, pg8::StaticOrder, PG8_ALIGN, PG8_SP2>(lds + RING_OFF, g, S, Eobj, wv); } while (0)

    if (IN(0)) { TID_DECL; LAS unsigned char* lds = LDSP; (void)lds;
        LAS float* scr = (LAS float*)(lds + RING_OFF + wave * 16384);
        if (I8_AIN_MASK || I8_CIN_MASK || I8_GU_MASK || I8_MGU_MASK) { LAS float* smax = (LAS float*)(lds + RING_OFF + 12288);
            p0_i8_stream(scr, smax, wave, lane, G); }
        for (int it = gw; it < 2 * IT_PER_J; it += NGW) p0_item(it, scr, lane);
#if P0_NOBAR
        __syncthreads();
#else
        if (BOTH(0)) GRID_BAR();
#endif
    }
#pragma unroll
    for (int lp = 0; lp < 2; ++lp) {
        const int pb = 1 + lp * PH_PER_LP, la = 2 * lp, lc = 2 * lp + 1;
        if (IN(pb + 0)) { TID_DECL; LAS unsigned char* lds = LDSP; (void)lds;
            const kargs_t KA = kargs();
            if (lp == 0) { if (I8_AIN_LP(lp)) norm_phase<1, false, 2>(lds, wave, lane, tid, KA->in[I_X], nullptr, nullptr, KA->in[I_MIXN] + (size_t)la * DM, (bf16*)(KA->ws + WS_H), nullptr,
                          KA->in[I_WINATT] + (size_t)lp * DM * ATT_SRC_LD + 3072, ATT_SRC_LD, KA->in[I_BFORGET] + lp * 8, (float*)(KA->ws + WS_LOGF), nullptr, nullptr, nullptr, (float*)(KA->ws + WS_SX)); else norm_phase<1, false, 0>(lds, wave, lane, tid, KA->in[I_X], nullptr, nullptr, KA->in[I_MIXN] + (size_t)la * DM, (bf16*)(KA->ws + WS_H), nullptr,
                          KA->in[I_WINATT] + (size_t)lp * DM * ATT_SRC_LD + 3072, ATT_SRC_LD, KA->in[I_BFORGET] + lp * 8, (float*)(KA->ws + WS_LOGF), nullptr, nullptr, nullptr, (float*)(KA->ws + WS_SX)); }
            else { if (I8_AIN_LP(lp)) norm_phase<1, true, 2>(lds, wave, lane, tid, KA->out, KA->out, (const bf16*)(KA->ws + WS_Y), KA->in[I_MIXN] + (size_t)la * DM, (bf16*)(KA->ws + WS_H), nullptr,
                          KA->in[I_WINATT] + (size_t)lp * DM * ATT_SRC_LD + 3072, ATT_SRC_LD, KA->in[I_BFORGET] + lp * 8, (float*)(KA->ws + WS_LOGF), nullptr, nullptr, nullptr, (float*)(KA->ws + WS_SX)); else norm_phase<1, true, 0>(lds, wave, lane, tid, KA->out, KA->out, (const bf16*)(KA->ws + WS_Y), KA->in[I_MIXN] + (size_t)la * DM, (bf16*)(KA->ws + WS_H), nullptr,
                          KA->in[I_WINATT] + (size_t)lp * DM * ATT_SRC_LD + 3072, ATT_SRC_LD, KA->in[I_BFORGET] + lp * 8, (float*)(KA->ws + WS_LOGF), nullptr, nullptr, nullptr, (float*)(KA->ws + WS_SX)); }
            if (BOTH(pb + 0)) GRID_BAR();
        }
        if (IN(pb + 1)) { LAS unsigned char* lds = LDSP; (void)lds;
            { TID_DECL; if (blockIdx.x < 32 && wave == 0) cumsum_seq((const float*)WSP(WS_LOGF), (float*)WSP(WS_C2), blockIdx.x, lane); }
            if (I8_AIN_LP(lp)) { pg8::EpiQKVT<true> E{(pg8::bf16_t*)WSP(WS_QKV), NATT, (unsigned*)WSP(WS_CTL) + CW_KMAX + lp * 128, (const float*)WSP(WS_SX), (const float*)WSP(WS_WSC) + WSC_AIN + lp * 6144};
                pg8::Gemm g{(const pg8::bf16_t*)WSP(WS_H), (const pg8::bf16_t*)WSP(WS_AIN + lp * SZ_AIN), M, NATT, DM / 2}; pg8::StaticOrder S; S.init(M, NATT, G, (int)blockIdx.x);
                pg8::gemm_phase<pg8::EpiQKVT<true>, pg8::StaticOrder, PG8_ALIGN, PG8_SP2, 2>(lds + RING_OFF, g, S, E, wv); }
            else { pg8::EpiQKV E{(pg8::bf16_t*)WSP(WS_QKV), NATT, (unsigned*)WSP(WS_CTL) + CW_KMAX + lp * 128};
                GEMM_PHASE(pg8::EpiQKV, WSP(WS_H), WSP(WS_AIN + lp * SZ_AIN), NATT, DM, E); }
            if (BOTH(pb + 1)) GRID_BAR();
        }
        if (IN(pb + 2)) { LAS unsigned char* lds = LDSP; (void)lds;
            if (AOUT8_LP(lp)) {
#if ATT_DYN_SB == 3
            att::attn_queue<FOX_EARLY_EXIT, SB_EARLY_EXIT, true>((char*)lds_raw + lds_off(), (const att::bf16*)WSP(WS_QKV), (const att::bf16*)WSP(WS_C2), (att::bf16*)WSP(WS_O), (const unsigned*)WSP(WS_CTL) + CW_KMAX + lp * 128,
                                                                       (unsigned*)WSP(WS_CTL) + CW_ATTQ + lp, (volatile unsigned*)(MISC + 16), wv, T0());
#else
#if ATT_DYN_SB != 2
            for (int L = blockIdx.x; L < 256; L += G) att::attn_stream<0, FOX_EARLY_EXIT, true>((char*)lds_raw + lds_off(), (const att::bf16*)WSP(WS_QKV), (const att::bf16*)WSP(WS_C2), (att::bf16*)WSP(WS_O), L, (const unsigned*)WSP(WS_CTL) + CW_KMAX + lp * 128, wv);
#endif
#if ATT_DYN_SB
            for (;;) {
                __syncthreads();
                if (T0()) MISC[16] = __hip_atomic_fetch_add((unsigned*)WSP(WS_CTL) + CW_ATTQ + lp, 1u, __ATOMIC_RELAXED, __HIP_MEMORY_SCOPE_AGENT);
                __syncthreads();
                const int it = __builtin_amdgcn_readfirstlane((int)MISC[16]);
#if ATT_DYN_SB == 2
                if (it >= 1024) break;
                if (it < 512) { att::attn_one<0, FOX_EARLY_EXIT, true>((char*)lds_raw + lds_off(), (const att::bf16*)WSP(WS_QKV), (const att::bf16*)WSP(WS_C2), (att::bf16*)WSP(WS_O), it & 31, 15 - (it >> 5), (const unsigned*)WSP(WS_CTL) + CW_KMAX + lp * 128, wv); continue; }
#else
                if (it >= 512) break;
#endif
                att::attn_one<1, SB_EARLY_EXIT, true>((char*)lds_raw + lds_off(), (const att::bf16*)WSP(WS_QKV), (const att::bf16*)WSP(WS_C2), (att::bf16*)WSP(WS_O), it & 31, 15 - ((it & 511) >> 5), nullptr, wv);
            }
#else
            for (int L = blockIdx.x; L < 256; L += G) att::attn_stream<1, SB_EARLY_EXIT, true>((char*)lds_raw + lds_off(), (const att::bf16*)WSP(WS_QKV), (const att::bf16*)WSP(WS_C2), (att::bf16*)WSP(WS_O), L, nullptr, wv);
#endif
#endif
            } else {
#if ATT_DYN_SB == 3
            att::attn_queue<FOX_EARLY_EXIT, SB_EARLY_EXIT, false>((char*)lds_raw + lds_off(), (const att::bf16*)WSP(WS_QKV), (const att::bf16*)WSP(WS_C2), (att::bf16*)WSP(WS_O), (const unsigned*)WSP(WS_CTL) + CW_KMAX + lp * 128,
                                                                       (unsigned*)WSP(WS_CTL) + CW_ATTQ + lp, (volatile unsigned*)(MISC + 16), wv, T0());
#else
#if ATT_DYN_SB != 2
            for (int L = blockIdx.x; L < 256; L += G) att::attn_stream<0, FOX_EARLY_EXIT, false>((char*)lds_raw + lds_off(), (const att::bf16*)WSP(WS_QKV), (const att::bf16*)WSP(WS_C2), (att::bf16*)WSP(WS_O), L, (const unsigned*)WSP(WS_CTL) + CW_KMAX + lp * 128, wv);
#endif
#if ATT_DYN_SB
#ifdef PROBE_ATT2
            for (int rep_ = 0; rep_ < PROBE_ATT2; ++rep_)
#else
            constexpr int rep_ = 0;
#endif
            for (;;) {
                __syncthreads();
#if ATT_XCDQ
                if (T0()) {
                    unsigned* qc = (unsigned*)WSP(WS_CTL) + CW_ATTQ2 + (lp * 2 + rep_) * 8; const int home = (int)blockIdx.x & 7; unsigned code = 0xFFFFu;
                    for (int k = 0; k < 8; ++k) { const int q = (home + k) & 7; const unsigned idx = __hip_atomic_fetch_add(qc + q, 1u, __ATOMIC_RELAXED, __HIP_MEMORY_SCOPE_AGENT);
                        if (idx < 128u) { const unsigned w = idx & 63u; code = (idx >> 6) * 512u + (w >> 2) * 32u + (unsigned)q + 8u * (w & 3u); break; } }
                    MISC[16] = code; }
#else
                if (T0()) MISC[16] = __hip_atomic_fetch_add((unsigned*)WSP(WS_CTL) + CW_ATTQ + lp + 2 * rep_, 1u, __ATOMIC_RELAXED, __HIP_MEMORY_SCOPE_AGENT);
#endif
                __syncthreads();
                const int it = __builtin_amdgcn_readfirstlane((int)MISC[16]);
#if ATT_DYN_SB == 2
                if (it >= 1024) break;
                if (it < 512) { att::attn_one<0, FOX_EARLY_EXIT, false>((char*)lds_raw + lds_off(), (const att::bf16*)WSP(WS_QKV), (const att::bf16*)WSP(WS_C2), (att::bf16*)WSP(WS_O), it & 31, 15 - (it >> 5), (const unsigned*)WSP(WS_CTL) + CW_KMAX + lp * 128, wv); continue; }
#else
                if (it >= 512) break;
#endif
                att::attn_one<1, SB_EARLY_EXIT, false>((char*)lds_raw + lds_off(), (const att::bf16*)WSP(WS_QKV), (const att::bf16*)WSP(WS_C2), (att::bf16*)WSP(WS_O), it & 31, 15 - ((it & 511) >> 5), nullptr, wv);
            }
#else
            for (int L = blockIdx.x; L < 256; L += G) att::attn_stream<1, SB_EARLY_EXIT, false>((char*)lds_raw + lds_off(), (const att::bf16*)WSP(WS_QKV), (const att::bf16*)WSP(WS_C2), (att::bf16*)WSP(WS_O), L, nullptr, wv);
#endif
#endif
            }
            if (BOTH(pb + 2)) GRID_BAR();
        }
        if (IN(pb + 3)) { LAS unsigned char* lds = LDSP; (void)lds;
            const kargs_t KA = kargs();
            pg8::EpiRes E{lp == 0 ? KA->in[I_X] : KA->out, KA->out, DM, nullptr, 0};
            if (AOUT8_LP(lp)) { pg8::Gemm g{(const pg8::bf16_t*)WSP(WS_O), (const pg8::bf16_t*)WSP(WS_AOUT + lp * SZ_SQ), M, DM, DM / 2, 0x7B7B7B7B}; pg8::StaticOrder S; S.init(M, DM, G, (int)blockIdx.x);
                pg8::gemm_phase<pg8::EpiRes, pg8::StaticOrder, PG8_ALIGN, PG8_SP2, 1>(lds + RING_OFF, g, S, E, wv); }
            else GEMM_PHASE(pg8::EpiRes, WSP(WS_O), WSP(WS_AOUT + lp * SZ_SQ), DM, DM, E);
            if (BOTH(pb + 3)) GRID_BAR();
        }
        if (IN(pb + 4)) { TID_DECL; LAS unsigned char* lds = LDSP; (void)lds;
            const kargs_t KA = kargs();
            if (I8_GU_LP(lp)) norm_phase<0, false, 2>(lds, wave, lane, tid, KA->out, nullptr, nullptr, KA->in[I_FFNN] + (size_t)la * DM, (bf16*)(KA->ws + WS_H), nullptr, nullptr, 0, nullptr, nullptr, nullptr, nullptr, nullptr, (float*)(KA->ws + WS_SX));
            else if (FFN_GU8_LP(lp)) norm_phase<0, false, 1>(lds, wave, lane, tid, KA->out, nullptr, nullptr, KA->in[I_FFNN] + (size_t)la * DM, (bf16*)(KA->ws + WS_H), nullptr, nullptr, 0, nullptr, nullptr, nullptr, nullptr, nullptr);
            else norm_phase<0, false, 0>(lds, wave, lane, tid, KA->out, nullptr, nullptr, KA->in[I_FFNN] + (size_t)la * DM, (bf16*)(KA->ws + WS_H), nullptr, nullptr, 0, nullptr, nullptr, nullptr, nullptr, nullptr);
            if (BOTH(pb + 4)) GRID_BAR();
        }
        if (IN(pb + 5)) { LAS unsigned char* lds = LDSP; (void)lds;
            if (I8_GU_LP(lp)) { pg8::Gemm g{(const pg8::bf16_t*)WSP(WS_H), (const pg8::bf16_t*)WSP(WS_GU + lp * SZ_GU), M, 2 * FF, DM / 2}; pg8::StaticOrder S; S.init(M, 2 * FF, G, (int)blockIdx.x);
                if (FFN_DN8_LP(lp)) { pg8::EpiSwiGLU8T<1> E{(unsigned char*)WSP(WS_ACT), FF, (const float*)WSP(WS_SX), (const float*)WSP(WS_WSC) + WSC_GU + lp * 11264, nullptr}; pg8::gemm_phase<pg8::EpiSwiGLU8T<1>, pg8::StaticOrder, PG8_ALIGN, PG8_SP2, 2>(lds + RING_OFF, g, S, E, wv); }
                else { pg8::EpiSwiGLUT<1> E{(pg8::bf16_t*)WSP(WS_ACT), FF, (const float*)WSP(WS_SX), (const float*)WSP(WS_WSC) + WSC_GU + lp * 11264, nullptr}; pg8::gemm_phase<pg8::EpiSwiGLUT<1>, pg8::StaticOrder, PG8_ALIGN, PG8_SP2, 2>(lds + RING_OFF, g, S, E, wv); } }
            else if (FFN_GU8_LP(lp)) { pg8::Gemm g{(const pg8::bf16_t*)WSP(WS_H), (const pg8::bf16_t*)WSP(WS_GU + lp * SZ_GU), M, 2 * FF, DM / 2}; pg8::StaticOrder S; S.init(M, 2 * FF, G, (int)blockIdx.x);
                if (FFN_DN8_LP(lp)) { pg8::EpiSwiGLU8 E{(unsigned char*)WSP(WS_ACT), FF}; pg8::gemm_phase<pg8::EpiSwiGLU8, pg8::StaticOrder, PG8_ALIGN, PG8_SP2, 1>(lds + RING_OFF, g, S, E, wv); }
                else { pg8::EpiSwiGLU E{(pg8::bf16_t*)WSP(WS_ACT), FF}; pg8::gemm_phase<pg8::EpiSwiGLU, pg8::StaticOrder, PG8_ALIGN, PG8_SP2, 1>(lds + RING_OFF, g, S, E, wv); } }
            else { if (FFN_DN8_LP(lp)) { pg8::EpiSwiGLU8 E{(unsigned char*)WSP(WS_ACT), FF}; GEMM_PHASE(pg8::EpiSwiGLU8, WSP(WS_H), WSP(WS_GU + lp * SZ_GU), 2 * FF, DM, E); }
                else { pg8::EpiSwiGLU E{(pg8::bf16_t*)WSP(WS_ACT), FF}; GEMM_PHASE(pg8::EpiSwiGLU, WSP(WS_H), WSP(WS_GU + lp * SZ_GU), 2 * FF, DM, E); } }
            if (BOTH(pb + 5)) GRID_BAR();
        }
        if (IN(pb + 6)) { LAS unsigned char* lds = LDSP; (void)lds;
            const kargs_t KA = kargs();
            pg8::EpiRes E{KA->out, KA->out, DM, nullptr, 0};
            if (FFN_DN8_LP(lp)) { pg8::Gemm g{(const pg8::bf16_t*)WSP(WS_ACT), (const pg8::bf16_t*)WSP(WS_DN + lp * SZ_DN), M, DM, FF / 2}; pg8::StaticOrder S; S.init(M, DM, G, (int)blockIdx.x);
                pg8::gemm_phase<pg8::EpiRes, pg8::StaticOrder, PG8_ALIGN, PG8_SP2, 1>(lds + RING_OFF, g, S, E, wv); }
            else GEMM_PHASE(pg8::EpiRes, WSP(WS_ACT), WSP(WS_DN + lp * SZ_DN), DM, FF, E);
            if (BOTH(pb + 6)) GRID_BAR();
        }
        if (IN(pb + 7)) { TID_DECL; LAS unsigned char* lds = LDSP; (void)lds;
            const kargs_t KA = kargs();
            if (I8_CIN_LP(lp)) norm_phase<0, false, 2>(lds, wave, lane, tid, KA->out, nullptr, nullptr, KA->in[I_MIXN] + (size_t)lc * DM, (bf16*)(KA->ws + WS_H), nullptr, nullptr, 0, nullptr, nullptr, nullptr, nullptr, nullptr, (float*)(KA->ws + WS_SX)); else norm_phase<0, false, 0>(lds, wave, lane, tid, KA->out, nullptr, nullptr, KA->in[I_MIXN] + (size_t)lc * DM, (bf16*)(KA->ws + WS_H), nullptr, nullptr, 0, nullptr, nullptr, nullptr, nullptr, nullptr, (float*)(KA->ws + WS_SX));
            if (BOTH(pb + 7)) GRID_BAR();
        }
        if (IN(pb + 8)) { LAS unsigned char* lds = LDSP; (void)lds;
            if (I8_CIN_LP(lp)) { pg8::EpiConvInT<true> E{(pg8::bf16_t*)WSP(WS_QKV), (const float*)WSP(WS_SX), (const float*)WSP(WS_WSC) + WSC_CIN + lp * 6144};
                pg8::Gemm g{(const pg8::bf16_t*)WSP(WS_H), (const pg8::bf16_t*)WSP(WS_CIN + lp * SZ_AIN), M, NATT, DM / 2}; pg8::StaticOrder S; S.init(M, NATT, G, (int)blockIdx.x);
                pg8::gemm_phase<pg8::EpiConvInT<true>, pg8::StaticOrder, PG8_ALIGN, PG8_SP2, 2>(lds + RING_OFF, g, S, E, wv); }
            else { pg8::EpiConvInT<false> E{(pg8::bf16_t*)WSP(WS_QKV), nullptr, nullptr};
                GEMM_PHASE(pg8::EpiConvInT<false>, WSP(WS_H), WSP(WS_CIN + lp * SZ_AIN), NATT, DM, E); }
            if (BOTH(pb + 8)) GRID_BAR();
        }
        if (IN(pb + 9)) { TID_DECL; LAS unsigned char* lds = LDSP; (void)lds;
            const kargs_t KA = kargs();
            if (COUT8_LP(lp)) conv_phase<true>((const bf16*)(KA->ws + WS_QKV), KA->in[I_CONVW] + (size_t)lp * 3 * DM, (bf16*)(KA->ws + WS_O), blockIdx.x * NWAVES * 64 + tid, G * NWAVES * 64);
            else conv_phase<false>((const bf16*)(KA->ws + WS_QKV), KA->in[I_CONVW] + (size_t)lp * 3 * DM, (bf16*)(KA->ws + WS_O), blockIdx.x * NWAVES * 64 + tid, G * NWAVES * 64);
            if (BOTH(pb + 9)) GRID_BAR();
        }
        if (IN(pb + 10)) { LAS unsigned char* lds = LDSP; (void)lds;
            const kargs_t KA = kargs();
            pg8::EpiRes E{KA->out, KA->out, DM, nullptr, 0};
            if (COUT8_LP(lp)) { pg8::Gemm g{(const pg8::bf16_t*)WSP(WS_O), (const pg8::bf16_t*)WSP(WS_COUT + lp * SZ_SQ), M, DM, DM / 2, 0x7E7E7E7E}; pg8::StaticOrder S; S.init(M, DM, G, (int)blockIdx.x);
                pg8::gemm_phase<pg8::EpiRes, pg8::StaticOrder, PG8_ALIGN, PG8_SP2, 1>(lds + RING_OFF, g, S, E, wv); }
            else GEMM_PHASE(pg8::EpiRes, WSP(WS_O), WSP(WS_COUT + lp * SZ_SQ), DM, DM, E);
            if (BOTH(pb + 10)) GRID_BAR();
        }
        if (IN(pb + 11)) { TID_DECL; LAS unsigned char* lds = LDSP; (void)lds;
            const kargs_t KA = kargs();
            if (I8_MGU_LP(lp)) norm_phase<4, false, 2>(lds, wave, lane, tid, KA->out, nullptr, nullptr, KA->in[I_FFNN] + (size_t)lc * DM, (bf16*)(KA->ws + WS_H), nullptr, KA->in[I_WROUTER] + (size_t)lp * DM * NE, NE, nullptr, nullptr,
                                 (unsigned*)(KA->ws + WS_CTL) + CW_MOECNT + lp * 64, (int*)(KA->ws + WS_MLIST), (float*)(KA->ws + WS_MGATE), (float*)(KA->ws + WS_SX), (float*)(KA->ws + WS_MSC));
            else if (MOE_FP8_LP(lp)) norm_phase<4, false, 1>(lds, wave, lane, tid, KA->out, nullptr, nullptr, KA->in[I_FFNN] + (size_t)lc * DM, (bf16*)(KA->ws + WS_H), nullptr, KA->in[I_WROUTER] + (size_t)lp * DM * NE, NE, nullptr, nullptr,
                                 (unsigned*)(KA->ws + WS_CTL) + CW_MOECNT + lp * 64, (int*)(KA->ws + WS_MLIST), (float*)(KA->ws + WS_MGATE));
            else norm_phase<4, false, 0>(lds, wave, lane, tid, KA->out, nullptr, nullptr, KA->in[I_FFNN] + (size_t)lc * DM, (bf16*)(KA->ws + WS_H), nullptr, KA->in[I_WROUTER] + (size_t)lp * DM * NE, NE, nullptr, nullptr,
                                 (unsigned*)(KA->ws + WS_CTL) + CW_MOECNT + lp * 64, (int*)(KA->ws + WS_MLIST), (float*)(KA->ws + WS_MGATE));
            if (BOTH(pb + 11)) GRID_BAR();
        }
        if (IN(pb + 12)) { LAS unsigned char* lds = LDSP; (void)lds;
            LAS int* tab = (LAS int*)(lds + MOETAB_OFF);
            int P; { TID_DECL; P = moe_table(tab, (const unsigned*)WSP(WS_CTL) + CW_MOECNT + lp * 64, tid); }
            if (I8_MGU_LP(lp)) {
                pg8::Gemm g{(const pg8::bf16_t*)WSP(WS_H), (const pg8::bf16_t*)WSP(WS_MGU + (size_t)(lp * NE) * SZ_MGU), P * 256, 2 * FFE, DM / 2};
                pg8::MoeOrder<true> S; S.init(P, 2 * FFE, G, (int)blockIdx.x, SZ_MGU, (const int*)WSP(WS_MLIST), tab);
                if (MOE_FP8_LP(lp)) { pg8::EpiSwiGLU8T<2> E{(unsigned char*)WSP(WS_ACT), FFE, (const float*)WSP(WS_MSC), (const float*)WSP(WS_WSC) + WSC_MGU + lp * NE * 5632, tab};
                    pg8::gemm_phase<pg8::EpiSwiGLU8T<2>, pg8::MoeOrder<true>, PG8_ALIGN, PG8_SP2, 2>(lds + RING_OFF, g, S, E, wv); }
                else { pg8::EpiSwiGLUT<2> E{(pg8::bf16_t*)WSP(WS_ACT), FFE, (const float*)WSP(WS_MSC), (const float*)WSP(WS_WSC) + WSC_MGU + lp * NE * 5632, tab};
                    pg8::gemm_phase<pg8::EpiSwiGLUT<2>, pg8::MoeOrder<true>, PG8_ALIGN, PG8_SP2, 2>(lds + RING_OFF, g, S, E, wv); }
            } else if (MOE_FP8_LP(lp)) {
                pg8::Gemm g{(const pg8::bf16_t*)WSP(WS_H), (const pg8::bf16_t*)WSP(WS_MGU + (size_t)(lp * NE) * SZ_MGU), P * 256, 2 * FFE, DM / 2};
                pg8::MoeOrder<true> S; S.init(P, 2 * FFE, G, (int)blockIdx.x, SZ_MGU, (const int*)WSP(WS_MLIST), tab);
                pg8::EpiSwiGLU8 E{(unsigned char*)WSP(WS_ACT), FFE};
                pg8::gemm_phase<pg8::EpiSwiGLU8, pg8::MoeOrder<true>, PG8_ALIGN, PG8_SP2, 1>(lds + RING_OFF, g, S, E, wv);
            } else {
                pg8::Gemm g{(const pg8::bf16_t*)WSP(WS_H), (const pg8::bf16_t*)WSP(WS_MGU + (size_t)(lp * NE) * SZ_MGU), P * 256, 2 * FFE, DM};
                pg8::MoeOrder<true> S; S.init(P, 2 * FFE, G, (int)blockIdx.x, SZ_MGU, (const int*)WSP(WS_MLIST), tab);
                pg8::EpiSwiGLU E{(pg8::bf16_t*)WSP(WS_ACT), FFE};
                pg8::gemm_phase<pg8::EpiSwiGLU, pg8::MoeOrder<true>, PG8_ALIGN, PG8_SP2>(lds + RING_OFF, g, S, E, wv);
            }
            if (BOTH(pb + 12)) GRID_BAR();
        }
        if (IN(pb + 13)) { LAS unsigned char* lds = LDSP; (void)lds;
            LAS int* tab = (LAS int*)(lds + MOETAB_OFF);
            int P; { TID_DECL; P = moe_table(tab, (const unsigned*)WSP(WS_CTL) + CW_MOECNT + lp * 64, tid); }
            pg8::MoeOrder<false> S; S.init(P, DM, G, (int)blockIdx.x, SZ_MDN, (const int*)WSP(WS_MLIST), tab);
            pg8::EpiMoeDown E{(pg8::bf16_t*)WSP(WS_Y), DM, (const int*)WSP(WS_MLIST), (const float*)WSP(WS_MGATE), tab};
            if (MOE_FP8_LP(lp)) { pg8::Gemm g{(const pg8::bf16_t*)WSP(WS_ACT), (const pg8::bf16_t*)WSP(WS_MDN + (size_t)(lp * NE) * SZ_MDN), P * 256, DM, FFE / 2};
                pg8::gemm_phase<pg8::EpiMoeDown, pg8::MoeOrder<false>, PG8_ALIGN, PG8_SP2, 1>(lds + RING_OFF, g, S, E, wv); }
            else { pg8::Gemm g{(const pg8::bf16_t*)WSP(WS_ACT), (const pg8::bf16_t*)WSP(WS_MDN + (size_t)(lp * NE) * SZ_MDN), P * 256, DM, FFE};
                pg8::gemm_phase<pg8::EpiMoeDown, pg8::MoeOrder<false>, PG8_ALIGN, PG8_SP2>(lds + RING_OFF, g, S, E, wv); }
            if (BOTH(pb + 13)) GRID_BAR();
        }
    }
    if (IN(NPHASES - 1)) { TID_DECL; LAS unsigned char* lds = LDSP; (void)lds;
        const kargs_t KA = kargs();
        norm_phase<3, true>(lds, wave, lane, tid, KA->out, nullptr, (const bf16*)(KA->ws + WS_Y), KA->in[I_FINN], nullptr, KA->out, nullptr, 0, nullptr, nullptr, nullptr, nullptr, nullptr);
    }
#undef IN
#undef BOTH
}

extern "C" void kernel_launch(void* const* d_in, const int* in_sizes, int n_in, void* d_out, int out_size, void* d_ws, size_t ws_size, hipStream_t stream) {
    static int grid = 0;
    if (grid == 0) {
        if (n_in != 17 || in_sizes[0] != M * DM || out_size != M * DM || ws_size < WS_END) { fprintf(stderr, "kernel_launch: shape/workspace mismatch: n_in %d in0 %d out %d ws %zu (need %zu)\n", n_in, n_in > 0 ? in_sizes[0] : -1, out_size, ws_size, (size_t)WS_END); grid = -1; return; }
        int dev = 0, cus = 0, per_cu = 0;
        if (hipGetDevice(&dev) != hipSuccess || hipDeviceGetAttribute(&cus, hipDeviceAttributeMultiprocessorCount, dev) != hipSuccess) { grid = -1; return; }
        if (hipFuncSetAttribute((const void*)mega_fwd, hipFuncAttributeMaxDynamicSharedMemorySize, LDS_BYTES) != hipSuccess) { fprintf(stderr, "kernel_launch: hipFuncSetAttribute failed\n"); grid = -1; return; }
        if (hipOccupancyMaxActiveBlocksPerMultiprocessor(&per_cu, (const void*)mega_fwd, NWAVES * 64, LDS_BYTES) != hipSuccess || per_cu < 1)
            fprintf(stderr, "kernel_launch: note: occupancy query reports %d workgroups per CU\n", per_cu);
        (void)hipGetLastError();
        grid = cus;
    }
    if (grid < 0) return;
    if (hipMemsetAsync((char*)d_ws + WS_CTL, 0, CTL_ZERO_BYTES, stream) != hipSuccess) { fprintf(stderr, "kernel_launch: memset failed\n"); return; }
    Args a{};
    for (int i = 0; i < 17; ++i) a.in[i] = (const float*)d_in[i];
    a.out = (float*)d_out; a.ws = (unsigned char*)d_ws;
    if (ONE_LAUNCH) {
#ifdef PROBE_DUPS
        const int dups[] = {PROBE_DUPS}; int start = 0, li = 0;
        for (int d : dups) { a.ph_lo = start; a.ph_hi = d + 1; a.li = li++; hipLaunchKernelGGL(mega_fwd, dim3(grid), dim3(NWAVES * 64), LDS_BYTES, stream, a); start = d; }
        a.ph_lo = start; a.ph_hi = NPHASES; a.li = li;
        hipLaunchKernelGGL(mega_fwd, dim3(grid), dim3(NWAVES * 64), LDS_BYTES, stream, a);
#else
        a.ph_lo = 0; a.ph_hi = NPHASES; a.li = 0;
        hipLaunchKernelGGL(mega_fwd, dim3(grid), dim3(NWAVES * 64), LDS_BYTES, stream, a);
#endif
    } else {
        for (int li = 0; li < NPHASES; ++li) { a.ph_lo = li; a.ph_hi = li + 1; a.li = li; hipLaunchKernelGGL(mega_fwd, dim3(grid), dim3(NWAVES * 64), LDS_BYTES, stream, a); }
    }
    const hipError_t le = hipPeekAtLastError();
    if (le != hipSuccess) fprintf(stderr, "kernel_launch: launch failed: %s\n", hipGetErrorName(le));
}
```

```cpp
#include <hip/hip_runtime.h>
#include <cstdio>
#include <cstdint>
#define MK_ONE_LAUNCH 1
#define SB_EARLY_EXIT true
#define FOX_EARLY_EXIT true
#define I8_AIN_MASK 3
#define I8_CIN_MASK 3
#define I8_GU_MASK 3
#define I8_MGU_MASK 3
#define FFN_GU8_MASK 0
#define FFN_DN8_MASK 2
__device__ __forceinline__ float lx(float v, int o, int lane) { return __uint_as_float((unsigned)__builtin_amdgcn_ds_bpermute((lane ^ o) << 2, (int)__float_as_uint(v))); }
__device__ __forceinline__ int lane_id_asm() { int l; asm volatile("v_mbcnt_lo_u32_b32 %0, -1, 0\n\tv_mbcnt_hi_u32_b32 %0, -1, %0" : "=v"(l)); return l; }
namespace pg8 {
#define PG8_LAS __attribute__((address_space(3)))
typedef unsigned short bf16_t;
typedef short bf16x8 __attribute__((ext_vector_type(8)));
typedef float f32x4 __attribute__((ext_vector_type(4)));
typedef int v8i_t __attribute__((ext_vector_type(8)));
typedef int v4i_t __attribute__((ext_vector_type(4)));
typedef short bf16x16_t __attribute__((ext_vector_type(16)));
template <bool F8> struct FragT { typedef bf16x8 A[4][2]; typedef bf16x8 B[2][2]; };
template <> struct FragT<true> { typedef v8i_t A[4]; typedef v8i_t B[2]; };
constexpr int FP8_SCALE_W = 0x79797979, FP8_SCALE_X = 0x7F7F7F7F;
typedef unsigned u32x4 __attribute__((ext_vector_type(4)));
constexpr int BM = 256, BK = 64, HALF = 128, HTB = HALF * BK * 2  , STAGE_BYTES = 8 * HTB, NXCD = 8, WGM = 4;

__host__ __device__ __forceinline__ int lds_byte(int r, int c) { const int st = (r >> 4) * 2 + (c >> 5), rr = r & 15, cc = c & 31, ob = rr * 64 + cc * 2; return st * 1024 + (ob ^ (((ob >> 9) & 1) << 5)); }
__host__ __device__ __forceinline__ void stage_rc(int b, int& R, int& C) { const int st = b / 1024, sb = b % 1024, swz = sb ^ (((sb >> 9) & 1) << 5); R = (st >> 1) * 16 + swz / 64; C = (st & 1) * 32 + (swz % 64) / 2; }
__host__ __device__ __forceinline__ int perm32(int rho) { const int n = rho >> 4, i = rho & 15; return 8 * (i >> 2) + 4 * n + (i & 3); }

struct Unit { int pm, pn; };
struct Gemm { const bf16_t* A; const bf16_t* Bt; int M, N, K; int sx8 = FP8_SCALE_X; };

struct StaticOrder {
    int nM, nN, nwg, G, c;
    __host__ __device__ void init(int M, int N, int G_, int c_) { nM = M / BM; nN = N / BM; nwg = nM * nN; G = G_; c = c_; }
    __host__ __device__ __forceinline__ bool next(int i, Unit& u) const {
        const long L = (long)i * G + c; if (L >= nwg) return false;
        int wgid = (int)L; { const int q = nwg / NXCD, r = nwg % NXCD, xcd = wgid % NXCD, off = wgid / NXCD; wgid = (xcd < r ? xcd * (q + 1) : r * (q + 1) + (xcd - r) * q) + off; }
        const int nig = WGM * nN, gid = wgid / nig, fm = gid * WGM, gsz = (nM - fm) < WGM ? (nM - fm) : WGM;
        u.pm = fm + ((wgid % nig) % gsz); u.pn = (wgid % nig) / gsz; return true;
    }
    static constexpr bool GATHER = false;
    __device__ __forceinline__ const char* bbase(const Unit&, const Gemm& g) const { return (const char*)g.Bt; }
    __device__ __forceinline__ int arow(const Unit&, int) const { return 0; }
    __device__ __forceinline__ void a_ready(const Unit&) const {}
    __device__ __forceinline__ void done(const Unit&) const {}
};
template <bool GATHER_> struct MoeOrder {
    static constexpr bool GATHER = GATHER_;
    int nM, nN, nwg, G, c; size_t bstride; const int* list; const PG8_LAS int* tab;
    __device__ void init(int P, int N, int G_, int c_, size_t bstride_, const int* list_, const PG8_LAS int* tab_) { nM = P; nN = N / BM; nwg = nM * nN; G = G_; c = c_; bstride = bstride_; list = list_; tab = tab_; }
    __device__ __forceinline__ bool next(int i, Unit& u) const {
        const long L = (long)i * G + c; if (L >= nwg) return false;
        int wgid = (int)L; { const int q = nwg / NXCD, r = nwg % NXCD, xcd = wgid % NXCD, off = wgid / NXCD; wgid = (xcd < r ? xcd * (q + 1) : r * (q + 1) + (xcd - r) * q) + off; }
        const int nig = WGM * nN, gid = wgid / nig, fm = gid * WGM, gsz = (nM - fm) < WGM ? (nM - fm) : WGM;
        u.pm = fm + ((wgid % nig) % gsz); u.pn = (wgid % nig) / gsz; return true;
    }
    __device__ __forceinline__ const char* bbase(const Unit& u, const Gemm& g) const { const int e = __builtin_amdgcn_readfirstlane(tab[8 + u.pm]); return (const char*)g.Bt + (size_t)e * bstride; }
    __device__ __forceinline__ int arow(const Unit& u, int r) const { const int e = tab[8 + u.pm], pos = tab[160 + u.pm] + r; return pos < tab[e] ? (list[e * 16384 + pos] >> 1) : 0; }
    __device__ __forceinline__ void a_ready(const Unit&) const {}
    __device__ __forceinline__ void done(const Unit&) const {}
};

__device__ __forceinline__ unsigned cvt_pk_bf16(float lo, float hi) { unsigned r; asm volatile("v_cvt_pk_bf16_f32 %0, %1, %2" : "=v"(r) : "v"(lo), "v"(hi)); return r; }
typedef float f32x2 __attribute__((ext_vector_type(2)));
typedef unsigned u32x2 __attribute__((ext_vector_type(2)));
template <bool I8> __device__ __forceinline__ f32x4 deq4(const f32x4 v, float s) {
    if (!I8) return v;
    f32x4 r; r[0] = (float)__float_as_int(v[0]) * s; r[1] = (float)__float_as_int(v[1]) * s; r[2] = (float)__float_as_int(v[2]) * s; r[3] = (float)__float_as_int(v[3]) * s; return r;
}
template <bool I8> __device__ __forceinline__ f32x4 deq4c(const f32x4 v, float s, const f32x4 c) {
    if (!I8) return v;
    f32x4 r; r[0] = (float)__float_as_int(v[0]) * s * c[0]; r[1] = (float)__float_as_int(v[1]) * s * c[1]; r[2] = (float)__float_as_int(v[2]) * s * c[2]; r[3] = (float)__float_as_int(v[3]) * s * c[3]; return r;
}
template <bool I8 = false>
struct EpiPlainBf16T {
    static constexpr bool PERM = true, AFTER_DRAIN = false;
    bf16_t* O; int ldc; const float* sx; const float* wsc;
    __device__ __forceinline__ void operator()(const f32x4 (&acc)[2][2][4][2], const Unit& u, int wr, int wc, int fr, int fq) const {
        const int row0 = u.pm * BM + wr * 64 + fr, col0 = u.pn * BM + wc * 32 + 8 * fq;
        f32x4 cs[2][2];
        if (I8) { cs[0][0] = *(const f32x4*)(wsc + col0); cs[0][1] = *(const f32x4*)(wsc + col0 + 4); cs[1][0] = *(const f32x4*)(wsc + col0 + HALF); cs[1][1] = *(const f32x4*)(wsc + col0 + HALF + 4); }
        float rs8[2][4];
#pragma unroll
        for (int ai = 0; ai < 2; ++ai)
#pragma unroll
            for (int m = 0; m < 4; ++m) rs8[ai][m] = I8 ? sx[row0 + ai * HALF + m * 16] : 1.0f;
#pragma unroll
        for (int ai = 0; ai < 2; ++ai)
#pragma unroll
            for (int m = 0; m < 4; ++m) { bf16_t* rowp = O + (size_t)(row0 + ai * HALF + m * 16) * ldc + col0;
                const float rsc = rs8[ai][m];
#pragma unroll
                for (int bj = 0; bj < 2; ++bj) { const f32x4 v0 = deq4c<I8>(acc[ai][bj][m][0], rsc, cs[bj][0]), v1 = deq4c<I8>(acc[ai][bj][m][1], rsc, cs[bj][1]);
                    u32x4 w; w.x = cvt_pk_bf16(v0[0], v0[1]); w.y = cvt_pk_bf16(v0[2], v0[3]); w.z = cvt_pk_bf16(v1[0], v1[1]); w.w = cvt_pk_bf16(v1[2], v1[3]);
                    *(u32x4*)(rowp + bj * HALF) = w; } }
    }
};
typedef EpiPlainBf16T<false> EpiPlainBf16;
template <bool I8 = false>
struct EpiConvInT {
    static constexpr bool PERM = true, AFTER_DRAIN = false;
    bf16_t* O; const float* sx; const float* wsc;
    __device__ __forceinline__ void operator()(const f32x4 (&acc)[2][2][4][2], const Unit& u, int wr, int wc, int fr, int fq) const {
        const int row0 = u.pm * BM + wr * 64 + fr, bc0 = u.pn * BM + wc * 32 + 8 * fq;
        f32x4 cs[2][2];
        if (I8) { cs[0][0] = *(const f32x4*)(wsc + bc0); cs[0][1] = *(const f32x4*)(wsc + bc0 + 4); cs[1][0] = *(const f32x4*)(wsc + bc0 + HALF); cs[1][1] = *(const f32x4*)(wsc + bc0 + HALF + 4); }
        float rs8[2][4];
#pragma unroll
        for (int ai = 0; ai < 2; ++ai)
#pragma unroll
            for (int m = 0; m < 4; ++m) rs8[ai][m] = I8 ? sx[row0 + ai * HALF + m * 16] : 1.0f;
        if (u.pn < 8) {
#pragma unroll
            for (int ai = 0; ai < 2; ++ai)
#pragma unroll
                for (int m = 0; m < 4; ++m) { bf16_t* rowp = O + (size_t)(row0 + ai * HALF + m * 16) * 4096 + bc0; const float rsc = rs8[ai][m];
#pragma unroll
                    for (int bj = 0; bj < 2; ++bj) { const f32x4 v0 = deq4c<I8>(acc[ai][bj][m][0], rsc, cs[bj][0]), v1 = deq4c<I8>(acc[ai][bj][m][1], rsc, cs[bj][1]);
                        u32x4 w; w.x = cvt_pk_bf16(v0[0], v0[1]); w.y = cvt_pk_bf16(v0[2], v0[3]); w.z = cvt_pk_bf16(v1[0], v1[1]); w.w = cvt_pk_bf16(v1[2], v1[3]);
                        *(u32x4*)(rowp + bj * HALF) = w; } }
        } else {
            const int col0 = 2048 + (u.pn - 8) * HALF + wc * 32 + 8 * fq;
#pragma unroll
            for (int ai = 0; ai < 2; ++ai)
#pragma unroll
                for (int m = 0; m < 4; ++m) { bf16_t* rowp = O + (size_t)(row0 + ai * HALF + m * 16) * 4096 + col0; const float rsc = rs8[ai][m];
                    const f32x4 g0 = deq4c<I8>(acc[ai][0][m][0], rsc, cs[0][0]), g1 = deq4c<I8>(acc[ai][0][m][1], rsc, cs[0][1]), u0 = deq4c<I8>(acc[ai][1][m][0], rsc, cs[1][0]), u1 = deq4c<I8>(acc[ai][1][m][1], rsc, cs[1][1]);
                    u32x4 w; w.x = cvt_pk_bf16(g0[0] * u0[0], g0[1] * u0[1]); w.y = cvt_pk_bf16(g0[2] * u0[2], g0[3] * u0[3]); w.z = cvt_pk_bf16(g1[0] * u1[0], g1[1] * u1[1]); w.w = cvt_pk_bf16(g1[2] * u1[2], g1[3] * u1[3]);
                    *(u32x4*)rowp = w; }
        }
    }
};
template <bool I8> __device__ __forceinline__ f32x4 swiglu4(const f32x4 ag, const f32x4 au, const f32x4 cg, const f32x4 cu, float rs) {
    f32x4 o;
#pragma unroll
    for (int h = 0; h < 2; ++h) {
        f32x2 g, ub;
        if (I8) { const f32x2 ig = {(float)__float_as_int(ag[2 * h]), (float)__float_as_int(ag[2 * h + 1])}, iu = {(float)__float_as_int(au[2 * h]), (float)__float_as_int(au[2 * h + 1])};
            const f32x2 cg2 = {cg[2 * h], cg[2 * h + 1]}, cu2 = {cu[2 * h], cu[2 * h + 1]}, rs2 = {rs, rs};
            g = (ig * cg2) * rs2; ub = (iu * cu2) * rs2; }
        else { g = (f32x2){ag[2 * h], ag[2 * h + 1]}; ub = (f32x2){au[2 * h], au[2 * h + 1]}; }
        const f32x2 mm = g * (f32x2){-1.4426950408889634f, -1.4426950408889634f};
        const f32x2 d = (f32x2){__builtin_amdgcn_exp2f(mm[0]), __builtin_amdgcn_exp2f(mm[1])} + (f32x2){1.0f, 1.0f};
        const f32x2 r = {__builtin_amdgcn_rcpf(d[0]), __builtin_amdgcn_rcpf(d[1])};
        const f32x2 res = (g * ub) * r;
        o[2 * h] = res[0]; o[2 * h + 1] = res[1];
    }
    return o;
}
__device__ __forceinline__ float silu_mul(float g, float u) { return g * __builtin_amdgcn_rcpf(1.0f + __builtin_amdgcn_exp2f(-1.4426950408889634f * g)) * u; }
template <int I8 = 0>
struct EpiSwiGLUT {
    static constexpr bool PERM = true, AFTER_DRAIN = false;
    bf16_t* O; int ldc; const float* sx; const float* wsc; const PG8_LAS int* tab;
    __device__ __forceinline__ void operator()(const f32x4 (&acc)[2][2][4][2], const Unit& u, int wr, int wc, int fr, int fq) const {
        const int row0 = u.pm * BM + wr * 64 + fr, col0 = u.pn * HALF + wc * 32 + 8 * fq;
        f32x4 cs[2][2]; int me = 0, mp = 0, mc = 0;
        if (I8 == 2) { me = tab[8 + u.pm]; mp = tab[160 + u.pm] + wr * 64 + fr; mc = tab[me]; }
        if (I8) { const float* wc_ = wsc + (I8 == 2 ? me * (2 * 2816) : 0) + u.pn * BM + wc * 32 + 8 * fq;
            cs[0][0] = *(const f32x4*)(wc_); cs[0][1] = *(const f32x4*)(wc_ + 4); cs[1][0] = *(const f32x4*)(wc_ + HALF); cs[1][1] = *(const f32x4*)(wc_ + HALF + 4); }
        float rs8[2][4];
#pragma unroll
        for (int ai = 0; ai < 2; ++ai)
#pragma unroll
            for (int m = 0; m < 4; ++m) { float r_ = 1.0f;
                if (I8 == 1) r_ = sx[row0 + ai * HALF + m * 16];
                if (I8 == 2) { const int pos = mp + ai * HALF + m * 16; r_ = pos < mc ? sx[me * 16384 + pos] : 0.f; }
                rs8[ai][m] = r_; }
#pragma unroll
        for (int ai = 0; ai < 2; ++ai)
#pragma unroll
            for (int m = 0; m < 4; ++m) { bf16_t* rowp = O + (size_t)(row0 + ai * HALF + m * 16) * ldc + col0;
                const float rsc = rs8[ai][m];
                const f32x4 s0 = swiglu4<(I8 != 0)>(acc[ai][0][m][0], acc[ai][1][m][0], cs[0][0], cs[1][0], rsc), s1 = swiglu4<(I8 != 0)>(acc[ai][0][m][1], acc[ai][1][m][1], cs[0][1], cs[1][1], rsc);
                u32x4 w; w.x = cvt_pk_bf16(s0[0], s0[1]); w.y = cvt_pk_bf16(s0[2], s0[3]); w.z = cvt_pk_bf16(s1[0], s1[1]); w.w = cvt_pk_bf16(s1[2], s1[3]);
                *(u32x4*)rowp = w; }
    }
};
typedef EpiSwiGLUT<0> EpiSwiGLU;
__device__ __forceinline__ unsigned pack_fp8x4(float a, float b, float c, float d) { int p = 0; p = __builtin_amdgcn_cvt_pk_fp8_f32(a, b, p, false); p = __builtin_amdgcn_cvt_pk_fp8_f32(c, d, p, true); return (unsigned)p; }
template <int I8 = 0>
struct EpiSwiGLU8T {
    static constexpr bool PERM = true, AFTER_DRAIN = false;
    unsigned char* O; int ldc; const float* sx; const float* wsc; const PG8_LAS int* tab;
    __device__ __forceinline__ void operator()(const f32x4 (&acc)[2][2][4][2], const Unit& u, int wr, int wc, int fr, int fq) const {
        const int row0 = u.pm * BM + wr * 64 + fr, col0 = u.pn * HALF + wc * 32 + 8 * fq;
        f32x4 cs[2][2]; int me = 0, mp = 0, mc = 0;
        if (I8 == 2) { me = tab[8 + u.pm]; mp = tab[160 + u.pm] + wr * 64 + fr; mc = tab[me]; }
        if (I8) { const float* wc_ = wsc + (I8 == 2 ? me * (2 * 2816) : 0) + u.pn * BM + wc * 32 + 8 * fq;
            cs[0][0] = *(const f32x4*)(wc_); cs[0][1] = *(const f32x4*)(wc_ + 4); cs[1][0] = *(const f32x4*)(wc_ + HALF); cs[1][1] = *(const f32x4*)(wc_ + HALF + 4); }
        float rs8[2][4];
#pragma unroll
        for (int ai = 0; ai < 2; ++ai)
#pragma unroll
            for (int m = 0; m < 4; ++m) { float r_ = 1.0f;
                if (I8 == 1) r_ = sx[row0 + ai * HALF + m * 16];
                if (I8 == 2) { const int pos = mp + ai * HALF + m * 16; r_ = pos < mc ? sx[me * 16384 + pos] : 0.f; }
                rs8[ai][m] = r_; }
#pragma unroll
        for (int ai = 0; ai < 2; ++ai)
#pragma unroll
            for (int m = 0; m < 4; ++m) { unsigned char* rowp = O + (size_t)(row0 + ai * HALF + m * 16) * ldc + col0;
                const float rsc = rs8[ai][m];
                const f32x4 s0 = swiglu4<(I8 != 0)>(acc[ai][0][m][0], acc[ai][1][m][0], cs[0][0], cs[1][0], rsc), s1 = swiglu4<(I8 != 0)>(acc[ai][0][m][1], acc[ai][1][m][1], cs[0][1], cs[1][1], rsc);
                u32x2 w; w.x = pack_fp8x4(s0[0], s0[1], s0[2], s0[3]); w.y = pack_fp8x4(s1[0], s1[1], s1[2], s1[3]);
                *(u32x2*)rowp = w; }
    }
};
typedef EpiSwiGLU8T<0> EpiSwiGLU8;
struct EpiRes {
    static constexpr bool PERM = false, AFTER_DRAIN = false;
    const float* base; float* out; int ldc; const float* rs; int rs_stride;
    __device__ __forceinline__ void operator()(const f32x4 (&acc)[2][2][4][2], const Unit& u, int wr, int wc, int fr, int fq) const {
        const int row0 = u.pm * BM + wr * 64 + fr, col0 = u.pn * BM + wc * 32 + 4 * fq;
        f32x4 b[2][2][2][2];
#define EPIRES_LD(buf, ap_) do { const int ai_ = (ap_) >> 1, mp_ = (ap_) & 1; _Pragma("unroll") for (int mm = 0; mm < 2; ++mm) { const size_t off = (size_t)(row0 + ai_ * HALF + (2 * mp_ + mm) * 16) * ldc + col0; \
            _Pragma("unroll") for (int bj = 0; bj < 2; ++bj) _Pragma("unroll") for (int n = 0; n < 2; ++n) b[buf][mm][bj][n] = *(const f32x4*)(base + off + bj * HALF + n * 16); } } while (0)
#define EPIRES_ST(buf, ap_) do { const int ai_ = (ap_) >> 1, mp_ = (ap_) & 1; _Pragma("unroll") for (int mm = 0; mm < 2; ++mm) { const int m = 2 * mp_ + mm; const size_t off = (size_t)(row0 + ai_ * HALF + m * 16) * ldc + col0; \
            _Pragma("unroll") for (int bj = 0; bj < 2; ++bj) _Pragma("unroll") for (int n = 0; n < 2; ++n) *(f32x4*)(out + off + bj * HALF + n * 16) = b[buf][mm][bj][n] + acc[ai_][bj][m][n]; } } while (0)
        EPIRES_LD(0, 0); asm volatile("" ::: "memory");
        EPIRES_LD(1, 1); asm volatile("" ::: "memory"); EPIRES_ST(0, 0); asm volatile("" ::: "memory");
        EPIRES_LD(0, 2); asm volatile("" ::: "memory"); EPIRES_ST(1, 1); asm volatile("" ::: "memory");
        EPIRES_LD(1, 3); asm volatile("" ::: "memory"); EPIRES_ST(0, 2); asm volatile("" ::: "memory");
        EPIRES_ST(1, 3); asm volatile("" ::: "memory");
#undef EPIRES_LD
#undef EPIRES_ST
    }
};
template <bool I8 = false>
struct EpiQKVT {
    static constexpr bool PERM = true, AFTER_DRAIN = false;
    bf16_t* O; int ldc; unsigned* kmax; const float* sx; const float* wsc;
    __device__ __forceinline__ void operator()(const f32x4 (&acc)[2][2][4][2], const Unit& u, int wr, int wc, int fr, int fq) const {
        const int row0 = u.pm * BM + wr * 64 + fr, col0 = u.pn * BM + wc * 32 + 8 * fq;
        float mx0 = 0.f, mx1 = 0.f;
        f32x4 cs[2][2];
        if (I8) { cs[0][0] = *(const f32x4*)(wsc + col0); cs[0][1] = *(const f32x4*)(wsc + col0 + 4); cs[1][0] = *(const f32x4*)(wsc + col0 + HALF); cs[1][1] = *(const f32x4*)(wsc + col0 + HALF + 4); }
        float rs8[2][4];
#pragma unroll
        for (int ai = 0; ai < 2; ++ai)
#pragma unroll
            for (int m = 0; m < 4; ++m) rs8[ai][m] = I8 ? sx[row0 + ai * HALF + m * 16] : 1.0f;
#pragma unroll
        for (int ai = 0; ai < 2; ++ai)
#pragma unroll
            for (int m = 0; m < 4; ++m) { bf16_t* rowp = O + (size_t)(row0 + ai * HALF + m * 16) * ldc + col0;
                const float rsc = rs8[ai][m];
#pragma unroll
                for (int bj = 0; bj < 2; ++bj) { const f32x4 v0 = deq4c<I8>(acc[ai][bj][m][0], rsc, cs[bj][0]), v1 = deq4c<I8>(acc[ai][bj][m][1], rsc, cs[bj][1]);
                    u32x4 w; w.x = cvt_pk_bf16(v0[0], v0[1]); w.y = cvt_pk_bf16(v0[2], v0[3]); w.z = cvt_pk_bf16(v1[0], v1[1]); w.w = cvt_pk_bf16(v1[2], v1[3]);
                    *(u32x4*)(rowp + bj * HALF) = w;
                    const float s = ((v0[0] * v0[0] + v0[1] * v0[1]) + (v0[2] * v0[2] + v0[3] * v0[3])) + ((v1[0] * v1[0] + v1[1] * v1[1]) + (v1[2] * v1[2] + v1[3] * v1[3]));
                    float t = s; t += lx(t, 16, fr + 16 * fq); t += lx(t, 32, fr + 16 * fq);
                    if (bj == 0) mx0 = fmaxf(mx0, t); else mx1 = fmaxf(mx1, t); } }
        if (u.pn >= 4 && u.pn < 8) {
#pragma unroll
            for (int o = 1; o < 16; o <<= 1) { mx0 = fmaxf(mx0, lx(mx0, o, fr + 16 * fq)); mx1 = fmaxf(mx1, lx(mx1, o, fr + 16 * fq)); }
            if (fr == 0 && fq == 0) { const int b = u.pm >> 4, h0 = (u.pn - 4) * 2;
                atomicMax(kmax + ((b * 8 + h0) * 4 + wc), __float_as_uint(mx0)); atomicMax(kmax + ((b * 8 + h0 + 1) * 4 + wc), __float_as_uint(mx1)); }
        }
    }
    __device__ __forceinline__ void init(f32x4 (&acc)[2][2][4][2], const Unit&, int, int, int, int) const {
#pragma unroll
        for (int a = 0; a < 2; ++a)
#pragma unroll
            for (int b = 0; b < 2; ++b)
#pragma unroll
                for (int m = 0; m < 4; ++m)
#pragma unroll
                    for (int n = 0; n < 2; ++n) acc[a][b][m][n] = (f32x4){0.f, 0.f, 0.f, 0.f};
    }
};
typedef EpiQKVT<false> EpiQKV;
struct EpiMoeDown {
    static constexpr bool PERM = true, AFTER_DRAIN = false;
    bf16_t* Y; int ldc; const int* list; const float* gate; const PG8_LAS int* tab;
    __device__ __forceinline__ void operator()(const f32x4 (&acc)[2][2][4][2], const Unit& u, int wr, int wc, int fr, int fq) const {
        const int e = tab[8 + u.pm], pbase = tab[160 + u.pm], cnt = tab[e];
        const int col0 = u.pn * BM + wc * 32 + 8 * fq;
        int sl8[2][4]; float gt8[2][4];
#pragma unroll
        for (int ai = 0; ai < 2; ++ai)
#pragma unroll
            for (int m = 0; m < 4; ++m) { const int pos = pbase + ai * HALF + wr * 64 + m * 16 + fr, pc = pos < cnt ? pos : cnt - 1; sl8[ai][m] = list[e * 16384 + pc]; gt8[ai][m] = gate[e * 16384 + pc]; }
#pragma unroll
        for (int ai = 0; ai < 2; ++ai)
#pragma unroll
            for (int m = 0; m < 4; ++m) { const int pos = pbase + ai * HALF + wr * 64 + m * 16 + fr;
                if (pos < cnt) { const int slot = sl8[ai][m]; const float gt = gt8[ai][m]; bf16_t* rowp = Y + (size_t)slot * ldc + col0;
#pragma unroll
                    for (int bj = 0; bj < 2; ++bj) { const f32x4 v0 = acc[ai][bj][m][0] * gt, v1 = acc[ai][bj][m][1] * gt;
                        u32x4 w; w.x = cvt_pk_bf16(v0[0], v0[1]); w.y = cvt_pk_bf16(v0[2], v0[3]); w.z = cvt_pk_bf16(v1[0], v1[1]); w.w = cvt_pk_bf16(v1[2], v1[3]);
                        *(u32x4*)(rowp + bj * HALF) = w; } } }
    }
};
template <class Epi, class Sched, bool ALIGN_EPI = false, bool SP2 = false, int LOWP = 0>
__device__ __forceinline__ void gemm_phase(PG8_LAS unsigned char* lds, const Gemm g, const Sched& S, const Epi& E, const int wv) {
    int tid_ = wv * 64 + lane_id_asm(); asm volatile("" : "+v"(tid_));
    const int tid = tid_, wid = __builtin_amdgcn_readfirstlane(tid >> 6), lane = tid & 63, wr = wid >> 2, wc = wid & 3, fr = lane & 15, fq = lane >> 4;
    const int K = g.K, nt = K / BK;
    constexpr bool FP8 = (LOWP == 1), I8 = (LOWP == 2);
    constexpr bool GATH = Sched::GATHER;
    unsigned voffB[2], vA0[2], vA1[2], nvA0[2], nvA1[2]; int sR[2], sC[2];
    const size_t kstep = (size_t)(BK * 2);
    const size_t hstep = (size_t)HALF * K * 2;
    const size_t tstep = 2 * hstep;
#pragma unroll
    for (int i = 0; i < 2; ++i) { int R, C; stage_rc(tid * 16 + i * 8192, R, C); const int Rb = Epi::PERM ? ((R & ~31) + perm32(R & 31)) : R; sR[i] = R; sC[i] = C;
        vA0[i] = (unsigned)(R * K + C) * 2u; vA1[i] = vA0[i] + (unsigned)hstep; nvA0[i] = vA0[i]; nvA1[i] = vA1[i]; voffB[i] = (unsigned)(Rb * K + C) * 2u; }
#define PG8_GROWS(U, d0, d1) do { _Pragma("unroll") for (int _i = 0; _i < 2; ++_i) { d0[_i] = (unsigned)(S.arow(U, sR[_i]) * K + sC[_i]) * 2u; d1[_i] = (unsigned)(S.arow(U, HALF + sR[_i]) * K + sC[_i]) * 2u; } } while (0)
    const unsigned ldsw = (unsigned)wid * 1024u;
    const int aoff = FP8 ? lds_byte(wr * 64 + fr, 16 * (fq & 1)) + (fq >> 1) * 1024 : lds_byte(wr * 64 + fr, fq * 8);
    const int boff = FP8 ? lds_byte(wc * 32 + fr, 16 * (fq & 1)) + (fq >> 1) * 1024 : lds_byte(wc * 32 + fr, fq * 8);
#define PG8_SA(b, h) (((b) * 2 + (h)) * HTB)
#define PG8_SB(b, h) ((4 + (b) * 2 + (h)) * HTB)
#define PG8_STAGE(bufoff, gbase, voff) do { _Pragma("unroll") for (int _i = 0; _i < 2; ++_i) \
        __builtin_amdgcn_global_load_lds((const unsigned*)((const char*)(gbase) + (voff)[_i]), (PG8_LAS unsigned*)(lds + (bufoff) + ldsw + _i * 8192), 16, 0, 0); } while (0)
#define PG8_CAT(x0, x1) (__builtin_bit_cast(v8i_t, (bf16x16_t)__builtin_shufflevector((x0), (x1), 0, 1, 2, 3, 4, 5, 6, 7, 8, 9, 10, 11, 12, 13, 14, 15)))
#define PG8_LDA(dst, b, h) do { if constexpr (FP8) { _Pragma("unroll") for (int m = 0; m < 4; ++m) { const PG8_LAS bf16x8* p_ = (const PG8_LAS bf16x8*)(lds + PG8_SA(b, h) + aoff + m * 2048); dst[m] = PG8_CAT(p_[0], p_[1]); } } \
        else { _Pragma("unroll") for (int m = 0; m < 4; ++m) _Pragma("unroll") for (int k = 0; k < 2; ++k) dst[m][k] = *(const PG8_LAS bf16x8*)(lds + PG8_SA(b, h) + aoff + m * 2048 + k * 1024); } } while (0)
#define PG8_LDB(dst, b, h) do { if constexpr (FP8) { _Pragma("unroll") for (int n = 0; n < 2; ++n) { const PG8_LAS bf16x8* p_ = (const PG8_LAS bf16x8*)(lds + PG8_SB(b, h) + boff + n * 2048); dst[n] = PG8_CAT(p_[0], p_[1]); } } \
        else { _Pragma("unroll") for (int n = 0; n < 2; ++n) _Pragma("unroll") for (int k = 0; k < 2; ++k) dst[n][k] = *(const PG8_LAS bf16x8*)(lds + PG8_SB(b, h) + boff + n * 2048 + k * 1024); } } while (0)
#define PG8_MMA(ai, bj, At, Bt) do { __builtin_amdgcn_s_setprio(1); if constexpr (FP8) { _Pragma("unroll") for (int m = 0; m < 4; ++m) _Pragma("unroll") for (int n = 0; n < 2; ++n) \
        asm volatile("v_mfma_scale_f32_16x16x128_f8f6f4 %0, %1, %2, %0, %3, %4 op_sel_hi:[0,0,0]" : "+v"(acc[ai][bj][m][n]) : "v"(Bt[n]), "v"(At[m]), "v"(f8sw), "v"(f8sx));     } else { \
        _Pragma("unroll") for (int m = 0; m < 4; ++m) _Pragma("unroll") for (int n = 0; n < 2; ++n) _Pragma("unroll") for (int k = 0; k < 2; ++k) { \
        if constexpr (I8) acc[ai][bj][m][n] = __builtin_bit_cast(f32x4, __builtin_amdgcn_mfma_i32_16x16x64_i8(__builtin_bit_cast(v4i_t, Bt[n][k]), __builtin_bit_cast(v4i_t, At[m][k]), __builtin_bit_cast(v4i_t, acc[ai][bj][m][n]), 0, 0, 0)); \
        else acc[ai][bj][m][n] = __builtin_amdgcn_mfma_f32_16x16x32_bf16(Bt[n][k], At[m][k], acc[ai][bj][m][n], 0, 0, 0); } } __builtin_amdgcn_s_setprio(0); } while (0)
#define PG8_WAIT_V(n) asm volatile("s_waitcnt vmcnt(" #n ")" ::: "memory")
#define PG8_WAIT_L(n) asm volatile("s_waitcnt lgkmcnt(" #n ")" ::: "memory")
#define PG8_BAR __builtin_amdgcn_s_barrier()
#define PG8_SCHED __builtin_amdgcn_sched_barrier(0)
    Unit cur, nxt; int ui = 0;
    if (!S.next(0, cur)) return;
#ifdef PG8_SKEW
    { const int sk_ = ((int)blockIdx.x >> 3) & 3;
      for (int i_ = 0; i_ < sk_; ++i_) __builtin_amdgcn_s_sleep(PG8_SKEW); }
#endif
    f32x4 acc[2][2][4][2];
#pragma unroll
    for (int a = 0; a < 2; ++a)
#pragma unroll
        for (int b = 0; b < 2; ++b)
#pragma unroll
            for (int m = 0; m < 4; ++m)
#pragma unroll
                for (int n = 0; n < 2; ++n) acc[a][b][m][n] = (f32x4){0.f, 0.f, 0.f, 0.f};
    const int f8sw = FP8_SCALE_W, f8sx = g.sx8; (void)f8sw; (void)f8sx;
    typename FragT<FP8>::A At; typename FragT<FP8>::B B0, B1;
    const char* cA = GATH ? (const char*)g.A : (const char*)g.A + (size_t)cur.pm * tstep; const char* cB = S.bbase(cur, g) + (size_t)cur.pn * tstep;
    if constexpr (GATH) { PG8_GROWS(cur, vA0, vA1); }
    S.a_ready(cur);
    if constexpr (SP2) {
        PG8_STAGE(PG8_SB(0, 0), cB, voffB); PG8_STAGE(PG8_SB(0, 1), cB + hstep, voffB); PG8_STAGE(PG8_SA(0, 0), cA, vA0); PG8_STAGE(PG8_SA(0, 1), cA, vA1);
        if (wr == 1) PG8_BAR;
        PG8_WAIT_V(2); PG8_BAR;
        PG8_STAGE(PG8_SB(1, 0), cB + kstep, voffB); PG8_STAGE(PG8_SA(1, 0), cA + kstep, vA0); PG8_STAGE(PG8_SB(1, 1), cB + hstep + kstep, voffB);
        PG8_WAIT_V(6); PG8_BAR;
    } else {
        PG8_STAGE(PG8_SB(0, 0), cB, voffB); PG8_STAGE(PG8_SA(0, 0), cA, vA0); PG8_STAGE(PG8_SB(0, 1), cB + hstep, voffB); PG8_STAGE(PG8_SA(0, 1), cA, vA1);
        if (wr == 1) PG8_BAR;
        PG8_WAIT_V(4); PG8_BAR;
        PG8_STAGE(PG8_SB(1, 0), cB + kstep, voffB); PG8_STAGE(PG8_SA(1, 0), cA + kstep, vA0); PG8_STAGE(PG8_SB(1, 1), cB + hstep + kstep, voffB);
        PG8_WAIT_V(6); PG8_BAR;
    }
    for (;;) {
        const bool has_next = S.next(ui + 1, nxt);
        const char* nA = (has_next && !GATH) ? (const char*)g.A + (size_t)nxt.pm * tstep : cA; const char* nB = has_next ? S.bbase(nxt, g) + (size_t)nxt.pn * tstep : cB;
        if constexpr (GATH) { if (has_next) { PG8_GROWS(nxt, nvA0, nvA1); } else {
#pragma unroll
            for (int i = 0; i < 2; ++i) { nvA0[i] = vA0[i]; nvA1[i] = vA1[i]; } } }
        for (int t = 0; t < nt; t += 2) {
            const bool last = (t == nt - 2);
            const char* a1 = cA + (size_t)(t + 1) * kstep;
            const char* a2 = last ? nA : cA + (size_t)(t + 2) * kstep; const char* b2 = last ? nB : cB + (size_t)(t + 2) * kstep;
            const char* a3 = a2 + kstep; const char* b3 = b2 + kstep;
            if (last && has_next) S.a_ready(nxt);
            unsigned xA0[2], xA1[2];
#pragma unroll
            for (int i = 0; i < 2; ++i) { xA0[i] = (GATH && last) ? nvA0[i] : vA0[i]; xA1[i] = (GATH && last) ? nvA1[i] : vA1[i]; }
            if constexpr (SP2) {
            PG8_LDB(B0, 0, 0); PG8_LDB(B1, 0, 1); PG8_SCHED; PG8_LDA(At, 0, 0); PG8_STAGE(PG8_SA(1, 1), a1, vA1);
            PG8_WAIT_V(8); PG8_WAIT_L(0); PG8_BAR; PG8_MMA(0, 0, At, B0); PG8_MMA(0, 1, At, B1); PG8_BAR; PG8_SCHED;
            PG8_LDA(At, 0, 1); PG8_STAGE(PG8_SB(0, 0), b2, voffB); PG8_STAGE(PG8_SB(0, 1), b2 + hstep, voffB); PG8_STAGE(PG8_SA(0, 0), a2, xA0);
            PG8_WAIT_V(8); PG8_WAIT_L(0); PG8_BAR; PG8_MMA(1, 0, At, B0); PG8_MMA(1, 1, At, B1); PG8_BAR; PG8_SCHED;
            PG8_LDB(B0, 1, 0); PG8_LDB(B1, 1, 1); PG8_SCHED; PG8_LDA(At, 1, 0); PG8_STAGE(PG8_SA(0, 1), a2, xA1);
            PG8_WAIT_V(8); PG8_WAIT_L(0); PG8_BAR; PG8_MMA(0, 0, At, B0); PG8_MMA(0, 1, At, B1); PG8_BAR; PG8_SCHED;
            PG8_LDA(At, 1, 1); PG8_STAGE(PG8_SB(1, 0), b3, voffB); PG8_STAGE(PG8_SB(1, 1), b3 + hstep, voffB); PG8_STAGE(PG8_SA(1, 0), a3, xA0);
            PG8_WAIT_V(8); PG8_WAIT_L(0); PG8_BAR; PG8_MMA(1, 0, At, B0); PG8_MMA(1, 1, At, B1); PG8_BAR; PG8_SCHED;
            } else {
            PG8_LDB(B0, 0, 0); PG8_SCHED; PG8_LDA(At, 0, 0); PG8_STAGE(PG8_SA(1, 1), a1, vA1);
            PG8_WAIT_L(8); PG8_BAR; PG8_WAIT_L(0); PG8_MMA(0, 0, At, B0); PG8_BAR; PG8_SCHED;
            PG8_LDB(B1, 0, 1); PG8_STAGE(PG8_SB(0, 0), b2, voffB);
            PG8_BAR; PG8_WAIT_L(0); PG8_MMA(0, 1, At, B1); PG8_BAR;
            PG8_LDA(At, 0, 1); PG8_STAGE(PG8_SA(0, 0), a2, xA0);
            PG8_BAR; PG8_WAIT_L(0); PG8_MMA(1, 0, At, B0); PG8_BAR; PG8_SCHED;
            PG8_STAGE(PG8_SB(0, 1), b2 + hstep, voffB);
            PG8_WAIT_V(6); PG8_BAR; PG8_MMA(1, 1, At, B1); PG8_BAR;
            PG8_LDB(B0, 1, 0); PG8_SCHED; PG8_LDA(At, 1, 0); PG8_STAGE(PG8_SA(0, 1), a2, xA1);
            PG8_WAIT_L(8); PG8_BAR; PG8_WAIT_L(0); PG8_MMA(0, 0, At, B0); PG8_BAR; PG8_SCHED;
            PG8_LDB(B1, 1, 1); PG8_STAGE(PG8_SB(1, 0), b3, voffB);
            PG8_BAR; PG8_WAIT_L(0); PG8_MMA(0, 1, At, B1); PG8_BAR;
            PG8_LDA(At, 1, 1); PG8_STAGE(PG8_SA(1, 0), a3, xA0);
            PG8_BAR; PG8_WAIT_L(0); PG8_MMA(1, 0, At, B0); PG8_BAR; PG8_SCHED;
            PG8_STAGE(PG8_SB(1, 1), b3 + hstep, voffB);
            PG8_WAIT_V(6); PG8_BAR; PG8_MMA(1, 1, At, B1); PG8_BAR;
            }
        }
        if constexpr (FP8) asm volatile("s_nop 15\n\ts_nop 15\n\ts_nop 15" ::: "memory");
        if constexpr (ALIGN_EPI) { if (wr == 0) PG8_BAR; }
        if constexpr (!Epi::AFTER_DRAIN) { E(acc, cur, wr, wc, fr, fq); S.done(cur); }
        if (!has_next) break;
#pragma unroll
        for (int a = 0; a < 2; ++a)
#pragma unroll
            for (int b = 0; b < 2; ++b)
#pragma unroll
                for (int m = 0; m < 4; ++m)
#pragma unroll
                    for (int n = 0; n < 2; ++n) acc[a][b][m][n] = (f32x4){0.f, 0.f, 0.f, 0.f};
        cur = nxt; cA = nA; cB = nB; ++ui;
        if constexpr (GATH) {
#pragma unroll
            for (int i = 0; i < 2; ++i) { vA0[i] = nvA0[i]; vA1[i] = nvA1[i]; } }
        if constexpr (ALIGN_EPI) { if (wr == 1) PG8_BAR; }
    }
    PG8_WAIT_V(0);
    if constexpr (!ALIGN_EPI) { if (wr == 0) PG8_BAR; }
    PG8_BAR;
    if constexpr (Epi::AFTER_DRAIN) { E.fused(acc, cur, wr, wc, fr, fq, lds, wid, lane); S.done(cur); }
#undef PG8_SA
#undef PG8_GROWS
#undef PG8_SB
#undef PG8_STAGE
#undef PG8_LDA
#undef PG8_LDB
#undef PG8_MMA
#undef PG8_CAT
#undef PG8_WAIT_V
#undef PG8_WAIT_L
#undef PG8_BAR
#undef PG8_SCHED
}
}
#ifndef FFN_FP8_MASK
#define FFN_FP8_MASK 2
#endif
#ifndef MOE_FP8_MASK
#define MOE_FP8_MASK 3
#endif
#ifndef I8_AIN_MASK
#define I8_AIN_MASK 0
#endif
#ifndef I8_CIN_MASK
#define I8_CIN_MASK 0
#endif
#define I8_AIN_LP(lp_) (((I8_AIN_MASK) >> (lp_)) & 1)
#define I8_CIN_LP(lp_) (((I8_CIN_MASK) >> (lp_)) & 1)
#ifndef AOUT8_MASK
#define AOUT8_MASK 0
#endif
#ifndef COUT8_MASK
#define COUT8_MASK 0
#endif
#define AOUT8_LP(lp_) (((AOUT8_MASK) >> (lp_)) & 1)
#define COUT8_LP(lp_) (((COUT8_MASK) >> (lp_)) & 1)
#ifndef FOX_CUT
#define FOX_CUT -64.0f
#endif
#ifndef SB_CUT_LOG2
#define SB_CUT_LOG2 -64.0f
#endif
#ifndef P0_NOBAR
#define P0_NOBAR 0
#endif
#ifndef ATT_DYN_SB
#define ATT_DYN_SB 2
#endif
#ifndef I8_MGU_MASK
#define I8_MGU_MASK 0
#endif
#define I8_MGU_LP(lp_) (((I8_MGU_MASK) >> (lp_)) & 1)
#ifndef I8_GU_MASK
#define I8_GU_MASK 0
#endif
#define I8_GU_LP(lp_) (((I8_GU_MASK) >> (lp_)) & 1)
#ifndef FFN_GU8_MASK
#define FFN_GU8_MASK FFN_FP8_MASK
#endif
#ifndef FFN_DN8_MASK
#define FFN_DN8_MASK FFN_FP8_MASK
#endif
#define FFN_GU8_LP(lp_) (((FFN_GU8_MASK) >> (lp_)) & 1)
#define FFN_DN8_LP(lp_) (((FFN_DN8_MASK) >> (lp_)) & 1)
#define MOE_FP8_LP(lp_) (((MOE_FP8_MASK) >> (lp_)) & 1)
#ifndef FOX_EARLY_EXIT
#define FOX_EARLY_EXIT false
#endif
#ifndef SB_EARLY_EXIT
#define SB_EARLY_EXIT false
#endif
#ifndef PG8_SP2
#define PG8_SP2 true
#endif
#ifndef PG8_ALIGN
#define PG8_ALIGN true
#endif
constexpr int NWAVES = 8;
constexpr int NBATCH = 4, SEQ = 4096, DM = 2048, M = NBATCH * SEQ;
constexpr int HD = 128, NHG = 8;
constexpr int NATT = 6144, ATT_SRC_LD = 6152;
constexpr int FF = 5632, NE = 8, FFE = 2816;
constexpr float RMS_EPS = 1e-6f;
constexpr float LOG2E = 1.4426950408889634f;
constexpr float QSCALE = 0.08838834764831845f * 1.4426950408889634f;

#ifndef MK_ONE_LAUNCH
#define MK_ONE_LAUNCH 1
#define SB_EARLY_EXIT true
#define FOX_EARLY_EXIT true
#define I8_AIN_MASK 3
#define I8_CIN_MASK 3
#define I8_GU_MASK 3
#define I8_MGU_MASK 3
#define FFN_GU8_MASK 0
#define FFN_DN8_MASK 2
#endif
constexpr int PH_PER_LP = 14;
constexpr int NPHASES = 1 + 2 * PH_PER_LP + 1;
constexpr bool ONE_LAUNCH = (MK_ONE_LAUNCH != 0);

constexpr int LDSCTL_OFF_FWD = 131072;
constexpr size_t MiB = 1u << 20;
constexpr size_t WS_CTL = 0, CTL_ZERO_BYTES = 1 * MiB;
constexpr size_t SZ_AIN = 24 * MiB, SZ_SQ = 8 * MiB, SZ_GU = 44 * MiB, SZ_DN = 22 * MiB, SZ_MGU = 22 * MiB, SZ_MDN = 11 * MiB;
constexpr size_t WS_AIN = 1 * MiB;
constexpr size_t WS_AOUT = WS_AIN + 2 * SZ_AIN;
constexpr size_t WS_CIN = WS_AOUT + 2 * SZ_SQ;
constexpr size_t WS_COUT = WS_CIN + 2 * SZ_AIN;
constexpr size_t WS_GU = WS_COUT + 2 * SZ_SQ;
constexpr size_t WS_DN = WS_GU + 2 * SZ_GU;
constexpr size_t WS_MGU = WS_DN + 2 * SZ_DN;
constexpr size_t WS_MDN = WS_MGU + 16 * SZ_MGU;
constexpr size_t WS_H = WS_MDN + 16 * SZ_MDN;
constexpr size_t WS_QKV = WS_H + 64 * MiB;
constexpr size_t WS_O = WS_QKV + 192 * MiB;
constexpr size_t WS_ACT = WS_O + 64 * MiB;
constexpr size_t WS_SMALL = WS_ACT + 192 * MiB;
constexpr size_t WS_LOGF = WS_SMALL;
constexpr size_t WS_C2 = WS_SMALL + 1 * MiB;
constexpr size_t WS_SX = WS_SMALL + 12 * MiB;
constexpr size_t WS_MSC = WS_SMALL + 10 * MiB;
constexpr size_t WS_WSC = WS_SMALL + 13 * MiB;
constexpr int WSC_AIN = 0, WSC_CIN = 2 * 6144, WSC_GU = 4 * 6144, WSC_MGU = 4 * 6144 + 2 * 11264;
constexpr size_t WS_MLIST = WS_SMALL + 8 * MiB;
constexpr size_t WS_MGATE = WS_SMALL + 9 * MiB;
constexpr size_t WS_Y = WS_QKV;
constexpr int CW_MOECNT = 2048;
constexpr int CW_ATTQ = 3400;
constexpr int CW_KMAX = 3072;
constexpr int MOETAB_OFF = LDSCTL_OFF_FWD + 1024;
constexpr size_t WS_KEXT = WS_SMALL + 4 * MiB;
constexpr size_t WS_END = WS_SMALL + 16 * MiB;
constexpr int CW_TMO = 0, CW_CODE = 1, CW_BAR = 4096;

constexpr int RING_OFF = 0, RING_BYTES = 131072;
constexpr int LDSCTL_OFF = RING_BYTES, MISC_OFF = LDSCTL_OFF + 320;
constexpr int LDS_BYTES = 147456;
#define GAS __attribute__((address_space(1)))
#define LAS __attribute__((address_space(3)))
typedef unsigned short bf16;
typedef unsigned v4u __attribute__((ext_vector_type(4)));
typedef float f32x4 __attribute__((ext_vector_type(4)));
typedef short bf16x8 __attribute__((ext_vector_type(8)));
typedef GAS unsigned gu32;
typedef GAS unsigned long long gu64;
#define RLX_AGENT __ATOMIC_RELAXED, __HIP_MEMORY_SCOPE_AGENT
#define LDS_WAIT() asm volatile("s_waitcnt lgkmcnt(0)" ::: "memory")
#define VM_WAIT() asm volatile("s_waitcnt vmcnt(0)" ::: "memory")
__device__ __forceinline__ unsigned long long rt() { return __builtin_amdgcn_s_memrealtime(); }
__device__ __forceinline__ unsigned f2bf(float f) { unsigned u = __builtin_bit_cast(unsigned, f); return (u + 0x7fffu + ((u >> 16) & 1u)) >> 16; }
__device__ __forceinline__ unsigned pk2(float lo, float hi) { return f2bf(lo) | (f2bf(hi) << 16); }

#define XB_TMO      128
#define XB_XCNT(j)  (256  + 64 * (j))
#define XB_XSUB(j)  (1280 + 64 * (j))
#define XB_XGEN(j)  (2304 + 64 * (j))
#define XB_TOP      3328
#define XB_TOPGEN   3392
#define XCD_BAR_WORDS 3456
#define XB_SPIN_CAP (1u << 24)

__device__ __forceinline__ unsigned xb_ld(unsigned* p)              { return __hip_atomic_load(p, __ATOMIC_RELAXED, __HIP_MEMORY_SCOPE_AGENT); }
__device__ __forceinline__ unsigned xb_add(unsigned* p, unsigned v) { return __hip_atomic_fetch_add(p, v, __ATOMIC_RELAXED, __HIP_MEMORY_SCOPE_AGENT); }
__device__ __forceinline__ unsigned xb_xcc_id() { return (unsigned)__builtin_amdgcn_s_getreg((3 << 11) | 20) & 0xFu; }
#define XB_SPIN(cond, bar) do { unsigned _sp = 0; while (cond) { __builtin_amdgcn_s_sleep(1); \
    if ((++_sp & 255u) == 0u) { if (xb_ld(&(bar)[XB_TMO])) break; if (_sp > XB_SPIN_CAP) { atomicAdd(&(bar)[XB_TMO], 1u); break; } } } } while (0)

struct XcdBarrier {
    unsigned* bar; unsigned x;
    volatile LAS unsigned* st;
};

__device__ __forceinline__ XcdBarrier xcd_barrier_post(unsigned* bar, volatile LAS unsigned* st, const bool t0) {
    XcdBarrier b; b.bar = bar; b.x = xb_xcc_id(); b.st = st;
    if (t0) (void)xb_add(&bar[XB_XCNT(b.x)], 1u);
    return b;
}
__device__ __forceinline__ void xcd_barrier_complete(unsigned* bar, unsigned x, unsigned& nloc, unsigned& nx) {
    const unsigned G = gridDim.x * gridDim.y * gridDim.z;
    unsigned sum, cnt, mine, sp = 0u;
    for (;;) {
        sum = 0u; cnt = 0u; mine = 0u;
#pragma unroll
        for (unsigned j = 0; j < 16; ++j) { const unsigned c = xb_ld(&bar[XB_XCNT(j)]); sum += c; cnt += (c > 0u) ? 1u : 0u; mine = (j == x) ? c : mine; }
        if (sum == G) break;
        __builtin_amdgcn_s_sleep(1);
        if ((++sp & 255u) == 0u) { if (xb_ld(&bar[XB_TMO])) break; if (sp > XB_SPIN_CAP) { atomicAdd(&bar[XB_TMO], 1u); break; } }
    }
    nloc = mine > 0u ? mine : 1u; nx = cnt > 0u ? cnt : 1u;
}

__device__ __forceinline__ void xcd_barrier(const XcdBarrier& b, const bool t0) {
    asm volatile("s_waitcnt vmcnt(0)" ::: "memory");
    __syncthreads();
    if (t0) {
        unsigned* bar = b.bar;
        __builtin_amdgcn_s_waitcnt(0);
        unsigned nloc = b.st[0], nx = b.st[1];
        if (nloc == 0u) { xcd_barrier_complete(bar, b.x, nloc, nx); b.st[0] = nloc; b.st[1] = nx; }
        const unsigned old = xb_add(&bar[XB_XSUB(b.x)], 1u);
        const unsigned gen = old / nloc;
        if (old + 1u == (gen + 1u) * nloc) {
            __builtin_amdgcn_fence(__ATOMIC_RELEASE, "agent");
            asm volatile("s_waitcnt vmcnt(0)" ::: "memory");
            const unsigned og = xb_add(&bar[XB_TOP], 1u);
            const unsigned tg = og / nx;
            if (og + 1u == (tg + 1u) * nx) xb_add(&bar[XB_TOPGEN], 1u);
            else XB_SPIN(xb_ld(&bar[XB_TOPGEN]) == tg, bar);
            __builtin_amdgcn_fence(__ATOMIC_ACQUIRE, "agent");
            xb_add(&bar[XB_XGEN(b.x)], 1u);
            asm volatile("s_waitcnt vmcnt(0)" ::: "memory");
        } else {
            XB_SPIN(xb_ld(&bar[XB_XGEN(b.x)]) == gen, bar);
            __builtin_amdgcn_fence(__ATOMIC_ACQUIRE, "agent");
            asm volatile("s_waitcnt vmcnt(0)" ::: "memory");
        }
    }
    __syncthreads();
}


namespace att {
typedef unsigned short bf16;
typedef short bf16x8 __attribute__((ext_vector_type(8)));
typedef short s16x4 __attribute__((ext_vector_type(4)));
typedef float f32x16 __attribute__((ext_vector_type(16)));
typedef float f32x4 __attribute__((ext_vector_type(4)));
typedef unsigned u32x4 __attribute__((ext_vector_type(4)));
constexpr int NW = 8, QBLK = 32, KVBLK = 64, QB = NW * QBLK, D = 128;
constexpr int LDQ = 6144, LDO = 2048;
constexpr int SHM_V = KVBLK * D * 2, SHM_K = KVBLK * D * 2;
constexpr int LDS_ATT = 2 * SHM_V + 2 * SHM_K + NW * 64 * 4;
constexpr float THR2 = 11.5415603f;
#define KSWZ(row, colB) ((row) * 256 + ((colB) ^ (((row) & 7) << 4)))
#define SBAR() __builtin_amdgcn_sched_barrier(0)
__device__ __forceinline__ int v_st(int k, int c) { const int kk = (k & ~0xC) | ((k & 4) << 1) | ((k & 8) >> 1); return ((kk >> 3) * 4 + (c >> 5)) * 512 + ((kk & 7) * 32 + (c & 31)) * 2; }
__device__ __forceinline__ int v_rd_base(int lane) { return ((lane & 3) << 3) | (((lane >> 2) & 3) << 6) | (((lane >> 4) & 1) << 5) | (((lane >> 5) & 1) << 8); }
constexpr int v_rd_off(int d0, int ks, int half) { return d0 * 512 + ks * 4096 + half * 2048; }
__device__ __forceinline__ int crow(int r, int hi) { return (r & 3) + 8 * (r >> 2) + 4 * hi; }
__device__ __forceinline__ unsigned cvtpk(float lo, float hi) { unsigned r; asm volatile("v_cvt_pk_bf16_f32 %0, %1, %2" : "=v"(r) : "v"(lo), "v"(hi)); return r; }
__device__ __forceinline__ bf16x8 load8(const bf16* p) { return *reinterpret_cast<const bf16x8*>(p); }
__device__ __forceinline__ void mask_tile(f32x16& p0, f32x16& p1, int dq) {
    const float NEG = -__builtin_inff();
#pragma unroll
    for (int r = 0; r < 16; ++r) { const int c = (r & 3) + 8 * (r >> 2);
        if (dq - c < 0) p0[r] = NEG;
        if (dq - c - 32 < 0) p1[r] = NEG; }
}
__device__ __forceinline__ void partialSM(f32x16& p0, f32x16& p1, float& m_reg, float& mn, float& alpha) {
    float pmax = p0[0];
#pragma unroll
    for (int r = 1; r < 16; ++r) pmax = fmaxf(pmax, p0[r]);
#pragma unroll
    for (int r = 0; r < 16; ++r) pmax = fmaxf(pmax, p1[r]);
    { auto rr = __builtin_amdgcn_permlane32_swap(__float_as_uint(pmax), __float_as_uint(pmax), false, false);
      pmax = fmaxf(__uint_as_float(rr[0]), __uint_as_float(rr[1])); }
    if (__builtin_expect(__all((pmax - m_reg) <= THR2), 1)) { mn = m_reg; alpha = 1.f; }
    else { mn = fmaxf(m_reg, pmax); alpha = __builtin_amdgcn_exp2f(m_reg - mn); m_reg = mn; }
#pragma unroll
    for (int r = 0; r < 16; ++r) p0[r] = p0[r] - mn;
#pragma unroll
    for (int r = 0; r < 16; ++r) p1[r] = p1[r] - mn;
#pragma unroll
    for (int r = 0; r < 16; ++r) p0[r] = __builtin_amdgcn_exp2f(p0[r]);
}
#define PK4(P, B_, OUT) do { unsigned a0 = cvtpk(P[B_+0], P[B_+1]), a1 = cvtpk(P[B_+2], P[B_+3]);                          \
        unsigned b0 = cvtpk(P[B_+4], P[B_+5]), b1 = cvtpk(P[B_+6], P[B_+7]);                                             \
        auto r0 = __builtin_amdgcn_permlane32_swap(a0, b0, false, false); auto r1 = __builtin_amdgcn_permlane32_swap(a1, b1, false, false); \
        u32x4 w = {r0[0], r1[0], r0[1], r1[1]}; OUT = *reinterpret_cast<bf16x8*>(&w); } while (0)
__device__ __forceinline__ void finishSM(f32x16& p0, f32x16& p1, float alpha, float& l_reg, bf16x8& pa0, bf16x8& pa1, bf16x8& pa2, bf16x8& pa3) {
#pragma unroll
    for (int r = 0; r < 16; ++r) p1[r] = __builtin_amdgcn_exp2f(p1[r]);
    float ps = 0;
#pragma unroll
    for (int r = 0; r < 16; ++r) ps += p0[r];
#pragma unroll
    for (int r = 0; r < 16; ++r) ps += p1[r];
    { auto rr = __builtin_amdgcn_permlane32_swap(__float_as_uint(ps), __float_as_uint(ps), false, false);
      ps = __uint_as_float(rr[0]) + __uint_as_float(rr[1]); }
    l_reg = l_reg * alpha + ps;
    PK4(p0, 0, pa0); PK4(p0, 8, pa1); PK4(p1, 0, pa2); PK4(p1, 8, pa3);
}
struct SbConst { bf16x8 pa0, pa1, ones; };
__device__ __forceinline__ SbConst sb_consts(int r32, int hi) {
    SbConst c; u32x4 w0, w1;
#pragma unroll
    for (int q = 0; q < 4; ++q) { unsigned a = 0, b = 0;
#pragma unroll
        for (int e = 0; e < 2; ++e) { const int jj = 2 * q + e; const int k0 = 8 * (jj >> 2) + 4 * hi + (jj & 3);
            if (k0 > r32) a |= 0x3F80u << (16 * e);
            if (16 + k0 > r32) b |= 0x3F80u << (16 * e); }
        w0[q] = a; w1[q] = b; }
    c.pa0 = *reinterpret_cast<bf16x8*>(&w0); c.pa1 = *reinterpret_cast<bf16x8*>(&w1);
    u32x4 o = {0x3F803F80u, 0x3F803F80u, 0x3F803F80u, 0x3F803F80u}; c.ones = *reinterpret_cast<bf16x8*>(&o);
    return c;
}
__device__ __forceinline__ void sb_math(f32x16& p0, f32x16& p1, float& R, bool key0_valid, int hi, const SbConst& C, bf16x8& pa0, bf16x8& pa1, bf16x8& pa2, bf16x8& pa3) {
    const float y00 = p0[0];
    f32x16 l0, l1;
#pragma unroll
    for (int r = 0; r < 16; ++r) { const float y = p0[r]; const float u = __builtin_amdgcn_logf(1.0f + __builtin_amdgcn_exp2f(-fabsf(y))); const float ln = fmaxf(y, 0.f) + u;
        l0[r] = (y == -__builtin_inff()) ? 0.f : ln; p0[r] = (y - ln) + R; }
#pragma unroll
    for (int r = 0; r < 16; ++r) { const float y = p1[r]; const float u = __builtin_amdgcn_logf(1.0f + __builtin_amdgcn_exp2f(-fabsf(y))); const float ln = fmaxf(y, 0.f) + u;
        l1[r] = (y == -__builtin_inff()) ? 0.f : ln; p1[r] = (y - ln) + R; }
    bf16x8 b00, b01, b10, b11;
    { u32x4 w = {cvtpk(-l0[0], -l0[1]), cvtpk(-l0[2], -l0[3]), cvtpk(-l0[4], -l0[5]), cvtpk(-l0[6], -l0[7])}; b00 = *reinterpret_cast<bf16x8*>(&w); }
    { u32x4 w = {cvtpk(-l0[8], -l0[9]), cvtpk(-l0[10], -l0[11]), cvtpk(-l0[12], -l0[13]), cvtpk(-l0[14], -l0[15])}; b01 = *reinterpret_cast<bf16x8*>(&w); }
    { u32x4 w = {cvtpk(-l1[0], -l1[1]), cvtpk(-l1[2], -l1[3]), cvtpk(-l1[4], -l1[5]), cvtpk(-l1[6], -l1[7])}; b10 = *reinterpret_cast<bf16x8*>(&w); }
    { u32x4 w = {cvtpk(-l1[8], -l1[9]), cvtpk(-l1[10], -l1[11]), cvtpk(-l1[12], -l1[13]), cvtpk(-l1[14], -l1[15])}; b11 = *reinterpret_cast<bf16x8*>(&w); }
    p0 = __builtin_amdgcn_mfma_f32_32x32x16_bf16(C.pa0, b00, p0, 0, 0, 0);
    p0 = __builtin_amdgcn_mfma_f32_32x32x16_bf16(C.pa1, b01, p0, 0, 0, 0);
    p0 = __builtin_amdgcn_mfma_f32_32x32x16_bf16(C.ones, b10, p0, 0, 0, 0);
    p0 = __builtin_amdgcn_mfma_f32_32x32x16_bf16(C.ones, b11, p0, 0, 0, 0);
    p1 = __builtin_amdgcn_mfma_f32_32x32x16_bf16(C.pa0, b10, p1, 0, 0, 0);
    p1 = __builtin_amdgcn_mfma_f32_32x32x16_bf16(C.pa1, b11, p1, 0, 0, 0);
    { const float rn = key0_valid ? (p0[0] - y00) : R; auto rr = __builtin_amdgcn_permlane32_swap(__float_as_uint(rn), __float_as_uint(rn), false, false); R = __uint_as_float(rr[0]); }
#pragma unroll
    for (int r = 0; r < 16; ++r) p0[r] = __builtin_amdgcn_exp2f(p0[r]);
#pragma unroll
    for (int r = 0; r < 16; ++r) p1[r] = __builtin_amdgcn_exp2f(p1[r]);
    PK4(p0, 0, pa0); PK4(p0, 8, pa1); PK4(p1, 0, pa2); PK4(p1, 8, pa3);
}
template <int KB, int MODE>
__device__ __forceinline__ void qkt(f32x16& p0, f32x16& p1, const char* K_lds, int r32, int hi, const bf16x8* qr, bool act, const bf16* kx, float& bl) {
    if (!act) { const float NEG = -__builtin_inff();
#pragma unroll
        for (int r = 0; r < 16; ++r) { p0[r] = NEG; p1[r] = NEG; } return; }
    float e0 = 0.f, e1 = 0.f;
    if (MODE == 0) { const float* cx = (const float*)kx; e0 = hi ? 0.f : -cx[0]; e1 = hi ? 0.f : -cx[32]; bl = e0; }
    p0 = f32x16{}; p1 = f32x16{};
    const char* kb[4];
#pragma unroll
    for (int dd = 0; dd < 4; ++dd) kb[dd] = K_lds + KB * SHM_K + KSWZ(r32, (dd * 16 + hi * 8) * 2);
#pragma unroll
    for (int d0 = 0; d0 < 8; ++d0) { const char* a = kb[d0 & 3] + (d0 >> 2) * 128;
        bf16x8 b0 = *reinterpret_cast<const bf16x8*>(a);
        bf16x8 b1 = *reinterpret_cast<const bf16x8*>(a + 32 * 256);
        p0 = __builtin_amdgcn_mfma_f32_32x32x16_bf16(b0, qr[d0], p0, 0, 0, 0);
        p1 = __builtin_amdgcn_mfma_f32_32x32x16_bf16(b1, qr[d0], p1, 0, 0, 0); }
    if (MODE == 0) { const float one = hi ? 0.f : 1.0f;
        p0 = __builtin_amdgcn_mfma_f32_32x32x2f32(e0, one, p0, 0, 0, 0);
        p1 = __builtin_amdgcn_mfma_f32_32x32x2f32(e1, one, p1, 0, 0, 0); }
}
template <int VB, bool SK>
__device__ __forceinline__ void pv_tile(f32x16* o, int vb0, bf16x8 pa0, bf16x8 pa1, bf16x8 pa2, bf16x8 pa3, bool act) {
    if (SK && !act) return;
#define TRRD(dst, off) asm volatile("ds_read_b64_tr_b16 %0, %1 offset:%2" : "=&v"(dst) : "v"(vb0), "i"(off) : "memory")
#define PV_D0(d0) do { s16x4 l0, l1, l2, l3, h0, h1, h2, h3; constexpr int b_ = VB * SHM_V + v_rd_off(d0, 0, 0);   \
        TRRD(l0, b_); TRRD(h0, b_ + 2048); TRRD(l1, b_ + 4096); TRRD(h1, b_ + 6144); TRRD(l2, b_ + 8192); TRRD(h2, b_ + 10240); TRRD(l3, b_ + 12288); TRRD(h3, b_ + 14336); \
        asm volatile("s_waitcnt lgkmcnt(0)" ::: "memory"); SBAR();   \
        o[d0] = __builtin_amdgcn_mfma_f32_32x32x16_bf16(pa0, (bf16x8){l0[0], l0[1], l0[2], l0[3], h0[0], h0[1], h0[2], h0[3]}, o[d0], 0, 0, 0);   \
        o[d0] = __builtin_amdgcn_mfma_f32_32x32x16_bf16(pa1, (bf16x8){l1[0], l1[1], l1[2], l1[3], h1[0], h1[1], h1[2], h1[3]}, o[d0], 0, 0, 0);   \
        o[d0] = __builtin_amdgcn_mfma_f32_32x32x16_bf16(pa2, (bf16x8){l2[0], l2[1], l2[2], l2[3], h2[0], h2[1], h2[2], h2[3]}, o[d0], 0, 0, 0);   \
        o[d0] = __builtin_amdgcn_mfma_f32_32x32x16_bf16(pa3, (bf16x8){l3[0], l3[1], l3[2], l3[3], h3[0], h3[1], h3[2], h3[3]}, o[d0], 0, 0, 0); } while (0)
    PV_D0(0); PV_D0(1); PV_D0(2); PV_D0(3);
#undef PV_D0
#undef TRRD
}
__device__ __forceinline__ unsigned pk_e4m3x4(float a, float b, float c, float d) { int p = 0; p = __builtin_amdgcn_cvt_pk_fp8_f32(a, b, p, false); p = __builtin_amdgcn_cvt_pk_fp8_f32(c, d, p, true); return (unsigned)p; }
struct BlockRef { const bf16* Qb; bf16* Ob; const bf16* KX; int P0; };
struct Seam { bf16x8 qr[8]; bf16x8 st_v0, st_v1, st_k0, st_k1; };
#define ROW(p, k0, rr) ((const bf16*)((const char*)(Qhb) + (unsigned)(((k0) + (rr)) * (LDQ * 2) + sc * 2 + (p))))
#define VMW() asm volatile("s_waitcnt vmcnt(0)" ::: "memory")
#define VMWN(n) asm volatile("s_waitcnt vmcnt(%0)" :: "i"(n) : "memory")
#define SLOAD_H(Kp, Vp, k0) do { const unsigned ro_ = (unsigned)(((k0) + sr) * (LDQ * 2) + sc * 2);                    \
                         S.st_v0 = load8((const bf16*)((const char*)(Qhb) + (ro_ + 4096u))); S.st_v1 = load8((const bf16*)((const char*)(Qhb) + (ro_ + 4096u + 32u * (LDQ * 2))));              \
                         S.st_k0 = load8((const bf16*)((const char*)(Qhb) + (ro_ + 2048u))); S.st_k1 = load8((const bf16*)((const char*)(Qhb) + (ro_ + 2048u + 32u * (LDQ * 2)))); } while (0)
#define SWRITE_HK(bf) do { *(bf16x8*)(K_lds + (bf) * SHM_K + kws) = S.st_k0; *(bf16x8*)(K_lds + (bf) * SHM_K + kws + 32 * 256) = S.st_k1; } while (0)
#define SWRITE_HV(bf) do { *(bf16x8*)(V_lds + (bf) * SHM_V + vst0) = S.st_v0; *(bf16x8*)(V_lds + (bf) * SHM_V + vst1) = S.st_v1; } while (0)
#define SWRITE_H(bf) do { SWRITE_HV(bf); SWRITE_HK(bf); } while (0)
__device__ __forceinline__ int first_tile(int P0) { return ((P0 + QB - 1) / KVBLK) * KVBLK; }
__device__ __forceinline__ void attn_prime(const BlockRef& cur, char* lds, Seam& S, const int wv) {
    const bf16* Qhb = cur.Qb;
    int tid_ = wv * 64 + lane_id_asm(); asm volatile("" : "+v"(tid_));
    const int tid = tid_, wid = __builtin_amdgcn_readfirstlane(tid >> 6), lane = tid & 63, r32 = lane & 31, hi = lane >> 5;
    const int sr = tid >> 4, sc = (tid & 15) * 8, kws = KSWZ(sr, sc * 2); char* K_lds = lds + 2 * SHM_V;
    const int kb0 = first_tile(cur.P0);
#pragma unroll
    for (int d0 = 0; d0 < 8; ++d0) S.qr[d0] = load8((const bf16*)((const char*)Qhb + (unsigned)((cur.P0 + wid * QBLK + r32) * (LDQ * 2) + d0 * 32 + hi * 16)));
    SLOAD_H(0, 0, kb0); VMW(); SWRITE_HK(0);
    __syncthreads();
}
template <int MODE, bool FEARLY, bool O8>
__device__ __forceinline__ void attn_block(const BlockRef& cur, const int nxtP0, const bf16* nxtQb, char* lds, Seam& S, const unsigned* kmax4, const int wv) {
    const bf16* Qhb = cur.Qb;
    constexpr bool SK = (MODE == 1) || FEARLY;
    int tid_ = wv * 64 + lane_id_asm(); asm volatile("" : "+v"(tid_));
    const int tid = tid_, wid = __builtin_amdgcn_readfirstlane(tid >> 6), lane = tid & 63, r32 = lane & 31, hi = lane >> 5;
    const int NT = first_tile(cur.P0) / KVBLK + 1;
    const int kbn = first_tile(nxtP0);
    const int qlo = cur.P0 + wid * QBLK, qm = qlo + r32 - 4 * hi - (MODE == 1 ? 1 : 0);
    char* V_lds = lds; char* K_lds = lds + 2 * SHM_V;
    float* ws = (float*)(lds + 2 * SHM_V + 2 * SHM_K) + wid * 64; float* li_l = ws, * al_l = ws + 32;
    const int li_rd = (int)(uintptr_t)li_l + 16 * hi, al_rd = li_rd + 128;
    float m_reg = -1e30f, l_reg = 0, Rsb = 0; f32x16 o[4] = {};
    const int sr = tid >> 4, sc = (tid & 15) * 8, vst0 = v_st(sr, sc), vst1 = v_st(32 + sr, sc), kws = KSWZ(sr, sc * 2);
    const int vb0 = (int)(uintptr_t)V_lds + v_rd_base(lane);
    SbConst SC; if (MODE == 1) SC = sb_consts(r32, hi);
    volatile int* flags = (volatile int*)(lds + 2 * SHM_V + 2 * SHM_K + NW * 64 * 4);
    float ubq = 0.f, bprev = 3.0e38f; bool fdone = false, alld = false; int nskip = 0;
    if (FEARLY) {
        if (lane == 0) flags[wid] = 0;
        float q2[4];
#pragma unroll
        for (int w = 0; w < 4; ++w) { float a = 0.f;
#pragma unroll
            for (int dd = 0; dd < 2; ++dd) { const bf16x8 f = S.qr[2 * w + dd];
#pragma unroll
                for (int j = 0; j < 8; ++j) { const float x = __uint_as_float(((unsigned)(unsigned short)f[j]) << 16); a += x * x; } }
            auto rr = __builtin_amdgcn_permlane32_swap(__float_as_uint(a), __float_as_uint(a), false, false); q2[w] = __uint_as_float(rr[0]) + __uint_as_float(rr[1]); }
        const unsigned kv = kmax4[lane & 3];
#pragma unroll
        for (int w = 0; w < 4; ++w) { const float k2 = __uint_as_float((unsigned)__builtin_amdgcn_readlane((int)kv, w)); ubq += __builtin_sqrtf(q2[w] * k2); }
        ubq *= 1.02f;
    }
#define LROW16(dst, basev) do { _Pragma("unroll") for (int r_ = 0; r_ < 16; ++r_) asm volatile("ds_read_b32 %0, %1 offset:%2" : "=v"(dst[r_]) : "v"(basev), "i"(4 * ((r_ & 3) + 8 * (r_ >> 2))) : "memory"); \
        asm volatile("s_waitcnt lgkmcnt(0)" ::: "memory"); SBAR(); } while (0)
#define RESC(a) do { if (MODE == 0) { if (__any((a) < 1.f)) { if (hi == 0) al_l[r32] = (a); asm volatile("s_waitcnt lgkmcnt(0)" ::: "memory");              \
                     float av_[16]; LROW16(av_, al_rd); for (int d_ = 0; d_ < 4; ++d_) for (int r = 0; r < 16; ++r) o[d_][r] *= av_[r]; } } } while (0)
#define KBASE(t) ((NT - 1 - (t)) * KVBLK)
#define ACT(t) ((KBASE(t) <= qlo + QBLK - 1) && !(FEARLY && fdone))
#define KXP(t) ((const bf16*)((const char*)cur.KX + (unsigned)((KBASE(t) + r32) * 4)))
#define FCHK() do { if (FEARLY) { if (!fdone) fdone = __all((ubq + bprev) - m_reg < (float)(FOX_CUT)) != 0; if (fdone) { if (++nskip == 2 && lane == 0) flags[wid] = 1; } } } while (0)
#define BLUPD(b) do { if (FEARLY) bprev = __uint_as_float((unsigned)__builtin_amdgcn_readlane((int)__float_as_uint(b), 0)); } while (0)
#define MASKT(P0_, P1_, t) do { const int kb_ = KBASE(t); if ((!SK || ACT(t)) && (kb_ + KVBLK - 1 > qlo - (MODE == 1 ? 1 : 0))) mask_tile(P0_, P1_, qm - kb_); } while (0)
#define FIN(PY0, PY1, alY, ty) do { if (MODE == 0) finishSM(PY0, PY1, alY, l_reg, pa0, pa1, pa2, pa3); else if (ACT(ty)) sb_math(PY0, PY1, Rsb, (qlo + r32) > KBASE(ty), hi, SC, pa0, pa1, pa2, pa3); } while (0)
#define PSM(PX0, PX1, mnX, alX) do { if (MODE == 0) partialSM(PX0, PX1, m_reg, mnX, alX); } while (0)
    constexpr int NQL = 8;
#define SEAM_K0() do { VMWN(NQL); SWRITE_HK(0); SBAR(); } while (0)
    f32x16 pA0, pA1, pB0, pB1; float mnA = 0, mnB = 0, alA = 1, alB = 1; bf16x8 pa0, pa1, pa2, pa3;
    SWRITE_HV(0); SBAR();
    if (NT > 1) { SLOAD_H(0, 0, KBASE(1)); }
    float bl = 0.f;
    SBAR(); qkt<0, MODE>(pA0, pA1, K_lds, r32, hi, S.qr, ACT(0), KXP(0), bl); if (ACT(0)) BLUPD(bl);
    MASKT(pA0, pA1, 0); PSM(pA0, pA1, mnA, alA);
    if (NT > 1) { VMW(); SWRITE_H(1); }
    __syncthreads();
#define HALF_STEP(PX0, PX1, mnX, alX, PY0, PY1, alY, t, KB, VB, SB) do {                                                      \
        FCHK(); SBAR(); qkt<KB, MODE>(PX0, PX1, K_lds, r32, hi, S.qr, ACT(t), KXP(t), bl); if (ACT(t)) BLUPD(bl);                                            \
        FIN(PY0, PY1, alY, (t) - 1); SBAR();                                                           \
        if ((t) + 1 < NT) { SLOAD_H(0, 0, KBASE((t) + 1)); SBAR(); }                                               \
        pv_tile<VB, SK>(o, vb0, pa0, pa1, pa2, pa3, ACT((t) - 1)); MASKT(PX0, PX1, (t)); PSM(PX0, PX1, mnX, alX);                                        \
        __syncthreads();                                                                                                      \
        if (FEARLY) { int c_ = 0; for (int w_ = 0; w_ < NW; ++w_) c_ += flags[w_]; alld = (c_ == NW); }     \
        if ((t) + 1 < NT) { VMW(); SWRITE_H(SB); }                                                                          \
        RESC(alX); __syncthreads(); } while (0)
    for (int t = 1; t + 1 < NT; t += 2) {
        HALF_STEP(pB0, pB1, mnB, alB, pA0, pA1, alA, t, 1, 0, 0);
        HALF_STEP(pA0, pA1, mnA, alA, pB0, pB1, alB, t + 1, 0, 1, 1);
        if (FEARLY && alld) break;
    }
    const bool even = (NT & 1) == 0;
    if (even && !alld) { FCHK(); SBAR(); qkt<1, MODE>(pB0, pB1, K_lds, r32, hi, S.qr, ACT(NT - 1), KXP(NT - 1), bl); SBAR(); }
    Qhb = nxtQb;
    SLOAD_H(0, 0, kbn); SBAR();
#pragma unroll
    for (int d0 = 0; d0 < 8; ++d0) S.qr[d0] = load8((const bf16*)((const char*)Qhb + (unsigned)((nxtP0 + wid * QBLK + r32) * (LDQ * 2) + d0 * 32 + hi * 16)));
    SBAR();
    if (!alld) {
    FIN(pA0, pA1, alA, (even ? NT - 2 : NT - 1)); SBAR();
    pv_tile<0, SK>(o, vb0, pa0, pa1, pa2, pa3, ACT(even ? NT - 2 : NT - 1));
    if (even) { MASKT(pB0, pB1, NT - 1); PSM(pB0, pB1, mnB, alB); __syncthreads(); RESC(alB);
        FIN(pB0, pB1, alB, NT - 1); SBAR(); pv_tile<1, SK>(o, vb0, pa0, pa1, pa2, pa3, ACT(NT - 1)); }
    }
    SBAR(); SEAM_K0();
    float rli[16];
    if (MODE == 0) { if (hi == 0) li_l[r32] = l_reg; asm volatile("s_waitcnt lgkmcnt(0)" ::: "memory");
        LROW16(rli, li_rd);
#pragma unroll
        for (int r = 0; r < 16; ++r) rli[r] = __builtin_amdgcn_rcpf(rli[r]); }
    else {
#pragma unroll
        for (int r = 0; r < 16; ++r) rli[r] = 1.f; }
    char* Ow = (char*)cur.Ob + (size_t)(cur.P0 + wid * QBLK) * (O8 ? LDO : LDO * 2);
    const int hi_e = lane_id_asm() >> 5;
#pragma unroll
    for (int r = 0; r < 16; ++r) { const int orow = crow(r, hi_e);
#pragma unroll
        for (int d0 = 0; d0 < 4; ++d0) { const float v = o[d0][r] * rli[r];
            if (O8) { const float v16 = v * 16.0f;
                const float v1 = __uint_as_float((unsigned)__builtin_amdgcn_mov_dpp((int)__float_as_uint(v16), 0x55, 0xf, 0xf, true)), v2 = __uint_as_float((unsigned)__builtin_amdgcn_mov_dpp((int)__float_as_uint(v16), 0xAA, 0xf, 0xf, true)),
                            v3 = __uint_as_float((unsigned)__builtin_amdgcn_mov_dpp((int)__float_as_uint(v16), 0xFF, 0xf, 0xf, true));
                if ((r32 & 3) == 0) *(unsigned*)(Ow + (unsigned)(orow * LDO + d0 * 32 + r32)) = pk_e4m3x4(v16, v1, v2, v3); }
            else {
            const float vn = __uint_as_float((unsigned)__builtin_amdgcn_mov_dpp((int)__float_as_uint(v), 0xB1, 0xf, 0xf, true));
            if ((r32 & 1) == 0) *(unsigned*)(Ow + (unsigned)(orow * (LDO * 2) + (d0 * 32 + r32) * 2)) = cvtpk(v, vn); } } }
    __syncthreads();
#undef RESC
#undef LROW16
#undef KBASE
#undef ACT
#undef KXP
#undef FCHK
#undef BLUPD
#undef MASKT
#undef FIN
#undef PSM
#undef SEAM_K0
#undef HALF_STEP
}
#undef ROW
#undef VMW
#undef VMWN
#undef SLOAD_H
#undef SWRITE_HK
#undef SWRITE_HV
#undef SWRITE_H
#undef PK4
constexpr float SB_CUT = (float)(SB_CUT_LOG2);
#define ROW(p, k0, rr) ((const bf16*)((const char*)(Qhb) + (unsigned)(((k0) + (rr)) * (LDQ * 2) + sc * 2 + (p))))
#define VMW() asm volatile("s_waitcnt vmcnt(0)" ::: "memory")
#define VMWN(n) asm volatile("s_waitcnt vmcnt(%0)" :: "i"(n) : "memory")
#define SLOAD_H(Kp, Vp, k0) do { const unsigned ro_ = (unsigned)(((k0) + sr) * (LDQ * 2) + sc * 2);                    \
                         S.st_v0 = load8((const bf16*)((const char*)(Qhb) + (ro_ + 4096u))); S.st_v1 = load8((const bf16*)((const char*)(Qhb) + (ro_ + 4096u + 32u * (LDQ * 2))));              \
                         S.st_k0 = load8((const bf16*)((const char*)(Qhb) + (ro_ + 2048u))); S.st_k1 = load8((const bf16*)((const char*)(Qhb) + (ro_ + 2048u + 32u * (LDQ * 2)))); } while (0)
#define SWRITE_HK(bf) do { *(bf16x8*)(K_lds + (bf) * SHM_K + kws) = S.st_k0; *(bf16x8*)(K_lds + (bf) * SHM_K + kws + 32 * 256) = S.st_k1; } while (0)
#define SWRITE_HV(bf) do { *(bf16x8*)(V_lds + (bf) * SHM_V + vst0) = S.st_v0; *(bf16x8*)(V_lds + (bf) * SHM_V + vst1) = S.st_v1; } while (0)
#define PK4(P, B_, OUT) do { unsigned a0 = cvtpk(P[B_+0], P[B_+1]), a1 = cvtpk(P[B_+2], P[B_+3]);                          \
        unsigned b0 = cvtpk(P[B_+4], P[B_+5]), b1 = cvtpk(P[B_+6], P[B_+7]);                                             \
        auto r0 = __builtin_amdgcn_permlane32_swap(a0, b0, false, false); auto r1 = __builtin_amdgcn_permlane32_swap(a1, b1, false, false); \
        u32x4 w = {r0[0], r1[0], r0[1], r1[1]}; OUT = *reinterpret_cast<bf16x8*>(&w); } while (0)
template <bool EARLY, bool O8>
__device__ __forceinline__ void sb_block(const BlockRef& cur, const int nxtP0, const bf16* nxtQb, char* lds, Seam& S, const int wv) {
    const bf16* Qhb = cur.Qb;
    int tid_ = wv * 64 + lane_id_asm(); asm volatile("" : "+v"(tid_));
    const int tid = tid_, wid = __builtin_amdgcn_readfirstlane(tid >> 6), lane = tid & 63, r32 = lane & 31, hi = lane >> 5;
    const int NT = first_tile(cur.P0) / KVBLK + 1;
    const int kbn = first_tile(nxtP0);
    const int qlo = cur.P0 + wid * QBLK, qm = qlo + r32 - 4 * hi - 1;
    char* V_lds = lds; char* K_lds = lds + 2 * SHM_V;
    volatile int* flags = (volatile int*)(lds + 2 * SHM_V + 2 * SHM_K);
    float Rsb = 0; f32x16 o[4] = {};
    const int sr = tid >> 4, sc = (tid & 15) * 8, vst0 = v_st(sr, sc), vst1 = v_st(32 + sr, sc), kws = KSWZ(sr, sc * 2);
    const int vb0 = (int)(uintptr_t)V_lds + v_rd_base(lane);
    if (EARLY && lane == 0) flags[wid] = 0;
    SWRITE_HV(0);
    bool wdone = false;
    for (int t = 0; t < NT; ++t) {
        const int kb_ = (NT - 1 - t) * KVBLK, bsel = t & 1;
        const bool more = t + 1 < NT;
        if (more) SLOAD_H(0, 0, kb_ - KVBLK);
        SBAR();
        const bool act = (kb_ <= qlo + QBLK - 1) && !wdone;
        bf16x8 pa0, pa1, pa2, pa3;
        if (act) {
            f32x16 p0 = {}, p1 = {};
            const char* kb[4];
#pragma unroll
            for (int dd = 0; dd < 4; ++dd) kb[dd] = K_lds + bsel * SHM_K + KSWZ(r32, (dd * 16 + hi * 8) * 2);
#pragma unroll
            for (int d0 = 0; d0 < 8; ++d0) { const char* a = kb[d0 & 3] + (d0 >> 2) * 128;
                bf16x8 b0 = *reinterpret_cast<const bf16x8*>(a);
                bf16x8 b1 = *reinterpret_cast<const bf16x8*>(a + 32 * 256);
                p0 = __builtin_amdgcn_mfma_f32_32x32x16_bf16(b0, S.qr[d0], p0, 0, 0, 0);
                p1 = __builtin_amdgcn_mfma_f32_32x32x16_bf16(b1, S.qr[d0], p1, 0, 0, 0); }
            if (kb_ + KVBLK - 1 > qlo - 1) mask_tile(p0, p1, qm - kb_);
            const float y00 = p0[0];
            bf16x8 b00, b01, b10, b11;
#define SBL(P, r) ({ const float y_ = P[r]; const float ln_ = fmaxf(y_, 0.f) + __builtin_amdgcn_logf(1.0f + __builtin_amdgcn_exp2f(-fabsf(y_))); P[r] = (y_ - ln_) + Rsb; -ln_; })
            { float n[16];
#pragma unroll
              for (int r = 0; r < 16; ++r) n[r] = SBL(p1, r);
              u32x4 w = {cvtpk(n[0], n[1]), cvtpk(n[2], n[3]), cvtpk(n[4], n[5]), cvtpk(n[6], n[7])}; b10 = *reinterpret_cast<bf16x8*>(&w);
              u32x4 w2 = {cvtpk(n[8], n[9]), cvtpk(n[10], n[11]), cvtpk(n[12], n[13]), cvtpk(n[14], n[15])}; b11 = *reinterpret_cast<bf16x8*>(&w2); }
            { float n[16];
#pragma unroll
              for (int r = 0; r < 16; ++r) n[r] = SBL(p0, r);
              u32x4 w = {cvtpk(n[0], n[1]), cvtpk(n[2], n[3]), cvtpk(n[4], n[5]), cvtpk(n[6], n[7])}; b00 = *reinterpret_cast<bf16x8*>(&w);
              u32x4 w2 = {cvtpk(n[8], n[9]), cvtpk(n[10], n[11]), cvtpk(n[12], n[13]), cvtpk(n[14], n[15])}; b01 = *reinterpret_cast<bf16x8*>(&w2); }
#undef SBL
            { const SbConst C = sb_consts(r32, hi);
              p1 = __builtin_amdgcn_mfma_f32_32x32x16_bf16(C.pa0, b10, p1, 0, 0, 0);
              p1 = __builtin_amdgcn_mfma_f32_32x32x16_bf16(C.pa1, b11, p1, 0, 0, 0);
              p0 = __builtin_amdgcn_mfma_f32_32x32x16_bf16(C.pa0, b00, p0, 0, 0, 0);
              p0 = __builtin_amdgcn_mfma_f32_32x32x16_bf16(C.pa1, b01, p0, 0, 0, 0);
              p0 = __builtin_amdgcn_mfma_f32_32x32x16_bf16(C.ones, b10, p0, 0, 0, 0);
              p0 = __builtin_amdgcn_mfma_f32_32x32x16_bf16(C.ones, b11, p0, 0, 0, 0); }
            { const float rn = ((qlo + r32) > kb_) ? (p0[0] - y00) : Rsb; auto rr = __builtin_amdgcn_permlane32_swap(__float_as_uint(rn), __float_as_uint(rn), false, false); Rsb = __uint_as_float(rr[0]); }
#pragma unroll
            for (int r = 0; r < 16; ++r) p0[r] = __builtin_amdgcn_exp2f(p0[r]);
#pragma unroll
            for (int r = 0; r < 16; ++r) p1[r] = __builtin_amdgcn_exp2f(p1[r]);
            PK4(p0, 0, pa0); PK4(p0, 8, pa1); PK4(p1, 0, pa2); PK4(p1, 8, pa3);
            if (EARLY) { wdone = __all(Rsb < SB_CUT) != 0; if (wdone && lane == 0) flags[wid] = 1; }
        }
        if (t == 0) __syncthreads();
        if (act) {
            const int vbt = vb0 + bsel * SHM_V;
#define TRRD(dst, off) asm volatile("ds_read_b64_tr_b16 %0, %1 offset:%2" : "=&v"(dst) : "v"(vbt), "i"(off) : "memory")
#define PV_D0(d0) do { s16x4 l0, l1, l2, l3, h0, h1, h2, h3; constexpr int b_ = v_rd_off(d0, 0, 0);   \
        TRRD(l0, b_); TRRD(h0, b_ + 2048); TRRD(l1, b_ + 4096); TRRD(h1, b_ + 6144); TRRD(l2, b_ + 8192); TRRD(h2, b_ + 10240); TRRD(l3, b_ + 12288); TRRD(h3, b_ + 14336); \
        asm volatile("s_waitcnt lgkmcnt(0)" ::: "memory"); SBAR();   \
        o[d0] = __builtin_amdgcn_mfma_f32_32x32x16_bf16(pa0, (bf16x8){l0[0], l0[1], l0[2], l0[3], h0[0], h0[1], h0[2], h0[3]}, o[d0], 0, 0, 0);   \
        o[d0] = __builtin_amdgcn_mfma_f32_32x32x16_bf16(pa1, (bf16x8){l1[0], l1[1], l1[2], l1[3], h1[0], h1[1], h1[2], h1[3]}, o[d0], 0, 0, 0);   \
        o[d0] = __builtin_amdgcn_mfma_f32_32x32x16_bf16(pa2, (bf16x8){l2[0], l2[1], l2[2], l2[3], h2[0], h2[1], h2[2], h2[3]}, o[d0], 0, 0, 0);   \
        o[d0] = __builtin_amdgcn_mfma_f32_32x32x16_bf16(pa3, (bf16x8){l3[0], l3[1], l3[2], l3[3], h3[0], h3[1], h3[2], h3[3]}, o[d0], 0, 0, 0); } while (0)
            PV_D0(0); PV_D0(1); PV_D0(2); PV_D0(3);
#undef PV_D0
#undef TRRD
        }
        asm volatile("s_waitcnt lgkmcnt(0)" ::: "memory");
        __syncthreads();
        bool alldone = false;
        if (EARLY) { int c = 0;
#pragma unroll
            for (int w = 0; w < NW; ++w) c += flags[w];
            alldone = (c == NW); }
        if (more && !alldone) { VMW(); SWRITE_HV(bsel ^ 1); SWRITE_HK(bsel ^ 1); }
        __syncthreads();
        if (alldone) break;
    }
    Qhb = nxtQb;
    SLOAD_H(0, 0, kbn); SBAR();
#pragma unroll
    for (int d0 = 0; d0 < 8; ++d0) S.qr[d0] = load8((const bf16*)((const char*)Qhb + (unsigned)((nxtP0 + wid * QBLK + r32) * (LDQ * 2) + d0 * 32 + hi * 16)));
    SBAR();
    VMWN(8); SWRITE_HK(0); SBAR();
    char* Ow = (char*)cur.Ob + (size_t)(cur.P0 + wid * QBLK) * (O8 ? LDO : LDO * 2);
    const int hi_e = lane_id_asm() >> 5;
#pragma unroll
    for (int r = 0; r < 16; ++r) { const int orow = crow(r, hi_e);
#pragma unroll
        for (int d0 = 0; d0 < 4; ++d0) { const float v = o[d0][r];
            if (O8) { const float v16 = v * 16.0f;
                const float v1 = __uint_as_float((unsigned)__builtin_amdgcn_mov_dpp((int)__float_as_uint(v16), 0x55, 0xf, 0xf, true)), v2 = __uint_as_float((unsigned)__builtin_amdgcn_mov_dpp((int)__float_as_uint(v16), 0xAA, 0xf, 0xf, true)),
                            v3 = __uint_as_float((unsigned)__builtin_amdgcn_mov_dpp((int)__float_as_uint(v16), 0xFF, 0xf, 0xf, true));
                if ((r32 & 3) == 0) *(unsigned*)(Ow + (unsigned)(orow * LDO + d0 * 32 + r32)) = pk_e4m3x4(v16, v1, v2, v3); }
            else {
            const float vn = __uint_as_float((unsigned)__builtin_amdgcn_mov_dpp((int)__float_as_uint(v), 0xB1, 0xf, 0xf, true));
            if ((r32 & 1) == 0) *(unsigned*)(Ow + (unsigned)(orow * (LDO * 2) + (d0 * 32 + r32) * 2)) = cvtpk(v, vn); } } }
    __syncthreads();
}
#undef ROW
#undef VMW
#undef VMWN
#undef SLOAD_H
#undef SWRITE_HK
#undef SWRITE_HV
#undef PK4
template <int MODE, bool EARLY, bool O8>
__device__ __forceinline__ void attn_stream(char* lds, const bf16* QKV, const bf16* KXall, bf16* O, int L, const unsigned* kmax, const int wv) {
    const int xcd = L & 7, k = L >> 3, bh = xcd * 4 + (k >> 3), x = k & 7, b = bh >> 3, h = bh & 7;
    const int qcol = (MODE == 0 ? 0 : 3072) + h * D;
    const bf16* Qb = QKV + (size_t)b * 4096 * LDQ + qcol;
    bf16* Ob = O8 ? (bf16*)((char*)O + ((size_t)b * 4096 * LDO + (MODE == 0 ? 0 : 1024) + h * D)) : O + (size_t)b * 4096 * LDO + (MODE == 0 ? 0 : 1024) + h * D;
    const bf16* KXb = KXall + (size_t)bh * 4096 * 2;
    Seam S;
    BlockRef cur{Qb, Ob, KXb, x * QB};
    attn_prime(cur, lds, S, wv);
    for (int pass = 0; pass < 2; ++pass) {
        const int qn = 15 - x;
        if (MODE == 0) attn_block<0, EARLY, O8>(cur, qn * QB, cur.Qb, lds, S, kmax + bh * 4, wv); else sb_block<EARLY, O8>(cur, qn * QB, cur.Qb, lds, S, wv);
        cur.P0 = qn * QB;
    }
}
template <int MODE, bool EARLY, bool O8>
__device__ __forceinline__ void attn_one(char* lds, const bf16* QKV, const bf16* KXall, bf16* O, int bh, int x, const unsigned* kmax, const int wv) {
    const int b = bh >> 3, h = bh & 7;
    const int qcol = (MODE == 0 ? 0 : 3072) + h * D;
    const bf16* Qb = QKV + (size_t)b * 4096 * LDQ + qcol;
    bf16* Ob = O8 ? (bf16*)((char*)O + ((size_t)b * 4096 * LDO + (MODE == 0 ? 0 : 1024) + h * D)) : O + (size_t)b * 4096 * LDO + (MODE == 0 ? 0 : 1024) + h * D;
    const bf16* KXb = KXall + (size_t)bh * 4096 * 2;
    Seam S;
    BlockRef cur{Qb, Ob, KXb, x * QB};
    attn_prime(cur, lds, S, wv);
    if (MODE == 0) attn_block<0, EARLY, O8>(cur, x * QB, cur.Qb, lds, S, kmax + bh * 4, wv); else sb_block<EARLY, O8>(cur, x * QB, cur.Qb, lds, S, wv);
}
template <bool FEARLY, bool SEARLY, bool O8>
__device__ __forceinline__ BlockRef queue_ref(const bf16* QKV, const bf16* KXall, bf16* O, int it) {
    const int bh = it & 31, x = 15 - ((it & 511) >> 5), md = it >> 9, b = bh >> 3, h = bh & 7;
    const size_t ocol = (size_t)b * 4096 * LDO + (md == 0 ? 0 : 1024) + h * D;
    BlockRef r; r.Qb = QKV + (size_t)b * 4096 * LDQ + (md == 0 ? 0 : 3072) + h * D; r.Ob = O8 ? (bf16*)((char*)O + ocol) : O + ocol; r.KX = KXall + (size_t)bh * 4096 * 2; r.P0 = x * QB; return r;
}
template <bool FEARLY, bool SEARLY, bool O8>
__device__ __forceinline__ void attn_queue(char* lds, const bf16* QKV, const bf16* KXall, bf16* O, const unsigned* kmax, unsigned* ctr, volatile unsigned* slot, const int wv, const bool t0) {
    __syncthreads();
    if (t0) *slot = __hip_atomic_fetch_add(ctr, 1u, __ATOMIC_RELAXED, __HIP_MEMORY_SCOPE_AGENT);
    __syncthreads();
    int it = __builtin_amdgcn_readfirstlane((int)*slot);
    if (it >= 1024) return;
    Seam S; BlockRef cur = queue_ref<FEARLY, SEARLY, O8>(QKV, KXall, O, it);
    attn_prime(cur, lds, S, wv);
    for (;;) {
        __syncthreads();
        if (t0) *slot = __hip_atomic_fetch_add(ctr, 1u, __ATOMIC_RELAXED, __HIP_MEMORY_SCOPE_AGENT);
        __syncthreads();
        const int nx = __builtin_amdgcn_readfirstlane((int)*slot); const bool has = nx < 1024;
        BlockRef nr = cur; if (has) nr = queue_ref<FEARLY, SEARLY, O8>(QKV, KXall, O, nx);
        if (it < 512) attn_block<0, FEARLY, O8>(cur, nr.P0, nr.Qb, lds, S, kmax + (it & 31) * 4, wv); else sb_block<SEARLY, O8>(cur, nr.P0, nr.Qb, lds, S, wv);
        if (!has) break;
        it = nx; cur = nr;
    }
}
}
__device__ __forceinline__ float wave_sum_l(float v, int lane) {
#pragma unroll
    for (int o = 1; o < 64; o <<= 1) v += lx(v, o, lane);
    return v;
}
#define wave_sum(v) wave_sum_l((v), lane)
__device__ __forceinline__ float wave_max_l(float v, int lane) {
#pragma unroll
    for (int o = 1; o < 64; o <<= 1) v = fmaxf(v, lx(v, o, lane));
    return v;
}
#define wave_max(v) wave_max_l((v), lane)
__device__ __forceinline__ float bf2f(unsigned short b) { return __uint_as_float((unsigned)b << 16); }
__device__ __forceinline__ float bflo(unsigned w) { return __uint_as_float(w << 16); }
__device__ __forceinline__ float bfhi(unsigned w) { return __uint_as_float(w & 0xffff0000u); }

__device__ __forceinline__ void tr_item(const float* W, int ldw, int K, bf16* WT, int kb, int src_col, int dst_row, float scale, LAS float* scr, int lane) {
    const int k0 = 64 * kb;
#pragma unroll
    for (int i = 0; i < 8; ++i) { const int kk = 8 * i + (lane >> 3), c4 = (lane & 7) * 4; const f32x4 w = *(const f32x4*)(W + (size_t)(k0 + kk) * ldw + src_col + c4);
        LAS float* d = scr + kk * 33 + c4; d[0] = w.x; d[1] = w.y; d[2] = w.z; d[3] = w.w; }
    LDS_WAIT(); asm volatile("" ::: "memory");
    const int c = lane & 7;
#pragma unroll
    for (int j = 0; j < 4; ++j) { const int n = (lane >> 3) + 8 * j; const LAS float* s = scr + (8 * c) * 33 + n;
        v4u o; o.x = pk2(s[0 * 33] * scale, s[1 * 33] * scale); o.y = pk2(s[2 * 33] * scale, s[3 * 33] * scale); o.z = pk2(s[4 * 33] * scale, s[5 * 33] * scale); o.w = pk2(s[6 * 33] * scale, s[7 * 33] * scale);
        *(GAS v4u*)(WT + (size_t)(dst_row + n) * K + k0 + 8 * c) = o; }
    LDS_WAIT(); asm volatile("" ::: "memory");
}
__device__ __forceinline__ void tr_item8(const float* W, int ldw, int K, unsigned char* WT, int kb, int src_col, int dst_row, float scale, LAS float* scr, int lane) {
    const int k0 = 64 * kb;
#pragma unroll
    for (int i = 0; i < 8; ++i) { const int kk = 8 * i + (lane >> 3), c4 = (lane & 7) * 4; const f32x4 w = *(const f32x4*)(W + (size_t)(k0 + kk) * ldw + src_col + c4);
        LAS float* d = scr + kk * 33 + c4; d[0] = w.x; d[1] = w.y; d[2] = w.z; d[3] = w.w; }
    LDS_WAIT(); asm volatile("" ::: "memory");
    const int c = lane & 3;
#pragma unroll
    for (int j = 0; j < 2; ++j) { const int n = (lane >> 2) + 16 * j; const LAS float* s = scr + (16 * c) * 33 + n;
        v4u o; o.x = pg8::pack_fp8x4(s[0 * 33] * scale, s[1 * 33] * scale, s[2 * 33] * scale, s[3 * 33] * scale); o.y = pg8::pack_fp8x4(s[4 * 33] * scale, s[5 * 33] * scale, s[6 * 33] * scale, s[7 * 33] * scale);
        o.z = pg8::pack_fp8x4(s[8 * 33] * scale, s[9 * 33] * scale, s[10 * 33] * scale, s[11 * 33] * scale); o.w = pg8::pack_fp8x4(s[12 * 33] * scale, s[13 * 33] * scale, s[14 * 33] * scale, s[15 * 33] * scale);
        *(GAS v4u*)(WT + (size_t)(dst_row + n) * K + k0 + 16 * c) = o; }
    LDS_WAIT(); asm volatile("" ::: "memory");
}
__device__ __forceinline__ unsigned pack_i8x4(float a, float b, float c, float d) {
    const int qa = (int)fminf(fmaxf(rintf(a), -127.f), 127.f), qb = (int)fminf(fmaxf(rintf(b), -127.f), 127.f), qc = (int)fminf(fmaxf(rintf(c), -127.f), 127.f), qd = (int)fminf(fmaxf(rintf(d), -127.f), 127.f);
    return (unsigned)(qa & 255) | ((unsigned)(qb & 255) << 8) | ((unsigned)(qc & 255) << 16) | ((unsigned)(qd & 255) << 24);
}
struct Args { const float* in[17]; float* out; unsigned char* ws; int ph_lo, ph_hi, li, pad; };
typedef const __attribute__((address_space(4))) Args* kargs_t;
__device__ __forceinline__ kargs_t kargs() { unsigned long long p = (unsigned long long)__builtin_amdgcn_kernarg_segment_ptr(); asm volatile("" : "+s"(p)); return (kargs_t)p; }
enum { I_X = 0, I_MIXN, I_FFNN, I_FINN, I_WINATT, I_BFORGET, I_WOUTATT, I_WINCONV, I_CONVW, I_WOUTCONV, I_WGD, I_WUD, I_WDD, I_WROUTER, I_WGM, I_WUM, I_WDM };
constexpr int IT_AIN = 8 * 192, IT_SQ = 8 * 64, IT_FF = 8 * 176, IT_DN = 22 * 64, IT_ME = 8 * 88, IT_MD = 11 * 64;
constexpr int IT_PER_J = 2 * IT_AIN + 2 * IT_SQ + 2 * IT_FF + IT_DN + NE * (2 * IT_ME + IT_MD);
__device__ __forceinline__ int cin_row(int nb) { const int seg = nb >> 6, c = 32 * (nb & 63); return seg == 0 ? c : 2048 + (c >> 7) * 256 + (seg == 2 ? 128 : 0) + (c & 127); }
template <int FMT>
__device__ __forceinline__ void tr_item4(const float* W, int ldw, int K, unsigned char* WT, int kb4, int src_col, int dst_row, float scale, LAS float* scr, int lane) {
    f32x4 w[4][8]; const int c4 = (lane & 7) * 4, k0 = 256 * kb4;
    const char* Wb = (const char*)(W + (size_t)k0 * ldw + src_col);
    const unsigned voff = (unsigned)((lane >> 3) * ldw + c4) * 4u;
#pragma unroll
    for (int q = 0; q < 4; ++q)
#pragma unroll
        for (int i = 0; i < 8; ++i) { const char* Wu = Wb + (size_t)((64 * q + 8 * i) * ldw) * 4; w[q][i] = __builtin_nontemporal_load((const f32x4*)(Wu + (size_t)voff)); }
#pragma unroll
    for (int q = 0; q < 4; ++q) {
#pragma unroll
        for (int i = 0; i < 8; ++i) { const int kk = 8 * i + (lane >> 3); LAS float* d = scr + kk * 33 + c4; d[0] = w[q][i].x; d[1] = w[q][i].y; d[2] = w[q][i].z; d[3] = w[q][i].w; }
        LDS_WAIT(); asm volatile("" ::: "memory");
        if (FMT == 0) { const int c = lane & 7;
#pragma unroll
            for (int j = 0; j < 4; ++j) { const int n = (lane >> 3) + 8 * j; const LAS float* s = scr + (8 * c) * 33 + n;
                v4u o; o.x = pk2(s[0 * 33] * scale, s[1 * 33] * scale); o.y = pk2(s[2 * 33] * scale, s[3 * 33] * scale); o.z = pk2(s[4 * 33] * scale, s[5 * 33] * scale); o.w = pk2(s[6 * 33] * scale, s[7 * 33] * scale);
                *(GAS v4u*)((bf16*)WT + (size_t)(dst_row + n) * K + k0 + 64 * q + 8 * c) = o; } }
        else { const int c = lane & 3;
#pragma unroll
            for (int j = 0; j < 2; ++j) { const int n = (lane >> 2) + 16 * j; const LAS float* s = scr + (16 * c) * 33 + n;
                v4u o; o.x = pg8::pack_fp8x4(s[0 * 33] * scale, s[1 * 33] * scale, s[2 * 33] * scale, s[3 * 33] * scale); o.y = pg8::pack_fp8x4(s[4 * 33] * scale, s[5 * 33] * scale, s[6 * 33] * scale, s[7 * 33] * scale);
                o.z = pg8::pack_fp8x4(s[8 * 33] * scale, s[9 * 33] * scale, s[10 * 33] * scale, s[11 * 33] * scale); o.w = pg8::pack_fp8x4(s[12 * 33] * scale, s[13 * 33] * scale, s[14 * 33] * scale, s[15 * 33] * scale);
                *(GAS v4u*)(WT + (size_t)(dst_row + n) * K + k0 + 64 * q + 16 * c) = o; } }
        LDS_WAIT(); asm volatile("" ::: "memory");
    }
}
__device__ __forceinline__ void p0_item(int it, LAS float* scr, int lane) {
    const kargs_t KA = kargs(); unsigned char* ws = KA->ws;
    const int j = it / IT_PER_J; int r = it - j * IT_PER_J;
    const float* W = nullptr; unsigned char* WT = nullptr; int ldw = 0, K = DM, kb4 = 0, src_col = 0, dst_row = 0, fmt = -1; float scale = 1.0f;
    if (r < IT_AIN) { kb4 = r / 192; const int nb = r % 192; const bool isq = (nb < 32) || (nb >= 96 && nb < 128);
        fmt = I8_AIN_LP(j) ? -1 : 0; W = KA->in[I_WINATT] + (size_t)j * DM * ATT_SRC_LD; ldw = ATT_SRC_LD; WT = ws + WS_AIN + j * SZ_AIN; src_col = 32 * nb + (nb >= 96 ? 8 : 0); dst_row = 32 * nb; scale = isq ? QSCALE : 1.0f; }
    else if ((r -= IT_AIN) < IT_SQ) { kb4 = r / 64; const int nb = r % 64;
        fmt = AOUT8_LP(j) ? 1 : 0; W = KA->in[I_WOUTATT] + (size_t)j * DM * DM; ldw = DM; WT = ws + WS_AOUT + j * SZ_SQ; src_col = 32 * nb; dst_row = 32 * nb; scale = AOUT8_LP(j) ? 64.0f : 1.0f; }
    else if ((r -= IT_SQ) < IT_AIN) { kb4 = r / 192; const int nb = r % 192;
        fmt = I8_CIN_LP(j) ? -1 : 0; W = KA->in[I_WINCONV] + (size_t)j * DM * 3 * DM; ldw = 3 * DM; WT = ws + WS_CIN + j * SZ_AIN; src_col = 32 * nb; dst_row = cin_row(nb); }
    else if ((r -= IT_AIN) < IT_SQ) { kb4 = r / 64; const int nb = r % 64;
        fmt = COUT8_LP(j) ? 1 : 0; W = KA->in[I_WOUTCONV] + (size_t)j * DM * DM; ldw = DM; WT = ws + WS_COUT + j * SZ_SQ; src_col = 32 * nb; dst_row = 32 * nb; scale = COUT8_LP(j) ? 64.0f : 1.0f; }
    else if ((r -= IT_SQ) < 2 * IT_FF) { const int up = r >= IT_FF; if (up) r -= IT_FF; kb4 = r / 176; const int nb = r % 176, n0 = 32 * nb;
        fmt = I8_GU_LP(j) ? -1 : (FFN_GU8_LP(j) ? 1 : 0); W = (up ? KA->in[I_WUD] : KA->in[I_WGD]) + (size_t)j * DM * FF; ldw = FF; WT = ws + WS_GU + j * SZ_GU; src_col = n0; dst_row = (n0 >> 7) * 256 + (up ? 128 : 0) + (n0 & 127); scale = FFN_GU8_LP(j) ? 64.0f : 1.0f; }
    else if ((r -= 2 * IT_FF) < IT_DN) { kb4 = r / 64; const int nb = r % 64;
        fmt = FFN_DN8_LP(j) ? 1 : 0; W = KA->in[I_WDD] + (size_t)j * FF * DM; ldw = DM; K = FF; WT = ws + WS_DN + j * SZ_DN; src_col = 32 * nb; dst_row = 32 * nb; scale = FFN_DN8_LP(j) ? 64.0f : 1.0f; }
    else { r -= IT_DN; const int e = r / (2 * IT_ME + IT_MD); r -= e * (2 * IT_ME + IT_MD); const int je = j * NE + e;
        if (r < 2 * IT_ME) { const int up = r >= IT_ME; if (up) r -= IT_ME; kb4 = r / 88; const int nb = r % 88, n0 = 32 * nb;
            fmt = I8_MGU_LP(j) ? -1 : (MOE_FP8_LP(j) ? 1 : 0); W = (up ? KA->in[I_WUM] : KA->in[I_WGM]) + (size_t)je * DM * FFE; ldw = FFE; WT = ws + WS_MGU + je * SZ_MGU; src_col = n0; dst_row = (n0 >> 7) * 256 + (up ? 128 : 0) + (n0 & 127); scale = MOE_FP8_LP(j) ? 64.0f : 1.0f; }
        else { r -= 2 * IT_ME; kb4 = r / 64; const int nb = r % 64;
            fmt = MOE_FP8_LP(j) ? 1 : 0; W = KA->in[I_WDM] + (size_t)je * FFE * DM; ldw = DM; K = FFE; WT = ws + WS_MDN + je * SZ_MDN; src_col = 32 * nb; dst_row = 32 * nb; scale = MOE_FP8_LP(j) ? 64.0f : 1.0f; } }
    if (fmt == 0) tr_item4<0>(W, ldw, K, WT, kb4, src_col, dst_row, scale, scr, lane);
    else if (fmt == 1) tr_item4<1>(W, ldw, K, WT, kb4, src_col, dst_row, scale, scr, lane);
}
constexpr int I8_PER_J = 192 + 192 + 352 + NE * 176;
struct I8D { const float* W; unsigned char* WT; float* wsc; int ldw, src_col, dst_row; float post; bool act; };
__device__ __forceinline__ I8D p0_i8_decode(int it) {
    const kargs_t KA = kargs(); unsigned char* ws = KA->ws; float* wsc = (float*)(ws + WS_WSC);
    I8D d; d.post = 1.0f; d.act = false; d.W = nullptr; d.WT = nullptr; d.wsc = wsc; d.ldw = 0; d.src_col = 0; d.dst_row = 0;
    if (it >= 2 * I8_PER_J) return d;
    const int j = it / I8_PER_J; int r = it - j * I8_PER_J;
    if (r < 192) { const int nb = r; const bool isq = (nb < 32) || (nb >= 96 && nb < 128);
        d.act = I8_AIN_LP(j); d.W = KA->in[I_WINATT] + (size_t)j * DM * ATT_SRC_LD; d.ldw = ATT_SRC_LD; d.WT = ws + WS_AIN + j * SZ_AIN; d.wsc = wsc + WSC_AIN + j * 6144; d.src_col = 32 * nb + (nb >= 96 ? 8 : 0); d.dst_row = 32 * nb; d.post = isq ? QSCALE : 1.0f; }
    else if (r < 384) { const int nb = r - 192;
        d.act = I8_CIN_LP(j); d.W = KA->in[I_WINCONV] + (size_t)j * DM * 3 * DM; d.ldw = 3 * DM; d.WT = ws + WS_CIN + j * SZ_AIN; d.wsc = wsc + WSC_CIN + j * 6144; d.src_col = 32 * nb; d.dst_row = cin_row(nb); }
    else if (r < 736) { r -= 384; const int up = r >= 176; if (up) r -= 176; const int n0 = 32 * r;
        d.act = I8_GU_LP(j); d.W = (up ? KA->in[I_WUD] : KA->in[I_WGD]) + (size_t)j * DM * FF; d.ldw = FF; d.WT = ws + WS_GU + j * SZ_GU; d.wsc = wsc + WSC_GU + j * 11264; d.src_col = n0; d.dst_row = (n0 >> 7) * 256 + (up ? 128 : 0) + (n0 & 127); }
    else { r -= 736; const int e = r / 176; r -= e * 176; const int je = j * NE + e; const int up = r >= 88; if (up) r -= 88; const int n0 = 32 * r;
        d.act = I8_MGU_LP(j); d.W = (up ? KA->in[I_WUM] : KA->in[I_WGM]) + (size_t)je * DM * FFE; d.ldw = FFE; d.WT = ws + WS_MGU + je * SZ_MGU; d.wsc = wsc + WSC_MGU + je * 5632; d.src_col = n0; d.dst_row = (n0 >> 7) * 256 + (up ? 128 : 0) + (n0 & 127); }
    return d;
}
__device__ __forceinline__ void p0_i8_stream(LAS float* scr, LAS float* smax, int wave, int lane, int G) {
    const int total = 2 * I8_PER_J;
    int it = blockIdx.x; I8D cur = p0_i8_decode(it);
    while (it < total && !cur.act) { it += G; cur = p0_i8_decode(it); }
    if (it >= total) return;
    f32x4 w[4][8]; const int c4 = (lane & 7) * 4;
#define I8_LOADQ(D_, q_) do { const unsigned vo_ = (unsigned)((64 * wave + (lane >> 3)) * (D_).ldw + (D_).src_col + c4) * 4u; \
        _Pragma("unroll") for (int i = 0; i < 8; ++i) { const char* Wu = (const char*)(D_).W + (size_t)((512 * (q_) + 8 * i) * (D_).ldw) * 4; w[q_][i] = __builtin_nontemporal_load((const f32x4*)(Wu + (size_t)vo_)); } } while (0)
    I8_LOADQ(cur, 0); I8_LOADQ(cur, 1); I8_LOADQ(cur, 2); I8_LOADQ(cur, 3);
    for (;;) {
        int nit = it + G; I8D nxt = p0_i8_decode(nit);
        while (nit < total && !nxt.act) { nit += G; nxt = p0_i8_decode(nit); }
        const bool has = nit < total;
        float cm0 = 0.f, cm1 = 0.f, cm2 = 0.f, cm3 = 0.f;
#pragma unroll
        for (int q = 0; q < 4; ++q)
#pragma unroll
            for (int i = 0; i < 8; ++i) { cm0 = fmaxf(cm0, fabsf(w[q][i].x)); cm1 = fmaxf(cm1, fabsf(w[q][i].y)); cm2 = fmaxf(cm2, fabsf(w[q][i].z)); cm3 = fmaxf(cm3, fabsf(w[q][i].w)); }
#pragma unroll
        for (int o = 8; o < 64; o <<= 1) { cm0 = fmaxf(cm0, lx(cm0, o, lane)); cm1 = fmaxf(cm1, lx(cm1, o, lane)); cm2 = fmaxf(cm2, lx(cm2, o, lane)); cm3 = fmaxf(cm3, lx(cm3, o, lane)); }
        if (lane < 8) { LAS float* d = smax + wave * 32 + c4; d[0] = cm0; d[1] = cm1; d[2] = cm2; d[3] = cm3; }
        __syncthreads();
        float mx0 = 0.f, mx1 = 0.f, mx2 = 0.f, mx3 = 0.f;
#pragma unroll
        for (int v = 0; v < 8; ++v) { const LAS float* s = smax + v * 32 + c4; mx0 = fmaxf(mx0, s[0]); mx1 = fmaxf(mx1, s[1]); mx2 = fmaxf(mx2, s[2]); mx3 = fmaxf(mx3, s[3]); }
        if (wave == 0 && lane < 8) { const float ps = cur.post / 127.0f; f32x4 o; o.x = mx0 * ps; o.y = mx1 * ps; o.z = mx2 * ps; o.w = mx3 * ps; *(f32x4*)(cur.wsc + cur.dst_row + c4) = o; }
        const float i0 = mx0 > 0.f ? 127.0f / mx0 : 0.f, i1 = mx1 > 0.f ? 127.0f / mx1 : 0.f, i2 = mx2 > 0.f ? 127.0f / mx2 : 0.f, i3 = mx3 > 0.f ? 127.0f / mx3 : 0.f;
#pragma unroll
        for (int q = 0; q < 4; ++q) { const int k0 = 64 * (wave + 8 * q);
#pragma unroll
            for (int i = 0; i < 8; ++i) { const int kk = 8 * i + (lane >> 3); LAS float* d = scr + kk * 33 + c4; d[0] = w[q][i].x * i0; d[1] = w[q][i].y * i1; d[2] = w[q][i].z * i2; d[3] = w[q][i].w * i3; }
            if (has) I8_LOADQ(nxt, q);
            LDS_WAIT(); asm volatile("" ::: "memory");
            const int c = lane & 3;
#pragma unroll
            for (int jj = 0; jj < 2; ++jj) { const int n = (lane >> 2) + 16 * jj; const LAS float* s = scr + (16 * c) * 33 + n;
                v4u o; o.x = pack_i8x4(s[0 * 33], s[1 * 33], s[2 * 33], s[3 * 33]); o.y = pack_i8x4(s[4 * 33], s[5 * 33], s[6 * 33], s[7 * 33]);
                o.z = pack_i8x4(s[8 * 33], s[9 * 33], s[10 * 33], s[11 * 33]); o.w = pack_i8x4(s[12 * 33], s[13 * 33], s[14 * 33], s[15 * 33]);
                *(GAS v4u*)(cur.WT + (size_t)(cur.dst_row + n) * DM + k0 + 16 * c) = o; }
            LDS_WAIT(); asm volatile("" ::: "memory");
        }
        __syncthreads();
        if (!has) break;
        cur = nxt; it = nit;
    }
#undef I8_LOADQ
}

template <int MODE, bool COMBINE, int OUTQ = 0>
__device__ __forceinline__ void norm_phase(LAS unsigned char* lds, int wave, int lane, int tid, const float* xin, float* xout, const bf16* Y, const float* gain, bf16* H, float* fout,
                                           const float* W8src, int w8ld, const float* bias8, float* ex_out, unsigned* mcnt, int* mlist, float* mgate, float* sx = nullptr, float* msc = nullptr) {
    const int G = gridDim.x;
    LAS float* W8t = (LAS float*)lds;
    LAS int* rt_e = (LAS int*)(lds + 65536); LAS float* rt_g = (LAS float*)(lds + 65536 + 256); LAS float* rt_s = (LAS float*)(lds + 65536 + 1024);
    if (MODE == 1 || MODE == 4) {
        for (int k = tid; k < DM; k += NWAVES * 64) { const f32x4 a = *(const f32x4*)(W8src + (size_t)k * w8ld), b = *(const f32x4*)(W8src + (size_t)k * w8ld + 4);
            W8t[0 * DM + k] = a.x; W8t[1 * DM + k] = a.y; W8t[2 * DM + k] = a.z; W8t[3 * DM + k] = a.w; W8t[4 * DM + k] = b.x; W8t[5 * DM + k] = b.y; W8t[6 * DM + k] = b.z; W8t[7 * DM + k] = b.w; }
        __syncthreads();
    }
    f32x4 gv[8];
#pragma unroll
    for (int j = 0; j < 8; ++j) gv[j] = ((const f32x4*)gain)[lane + 64 * j];
    const int npass = (MODE == 4) ? (M / 64 + G - 1) / G : (M + G * NWAVES - 1) / (G * NWAVES);
    constexpr int RPP = (MODE == 4) ? 8 : 1;
#define NROW(it_) ((MODE == 4) ? (blockIdx.x + ((it_) >> 3) * G) * 64 + wave * 8 + ((it_) & 7) : (blockIdx.x * NWAVES + wave) + (it_) * (G * NWAVES))
#define NROW_OK(it_) ((it_) < npass * RPP && NROW(it_) < M)
    f32x4 vn[8]; uint2 yn0[COMBINE ? 8 : 1], yn1[COMBINE ? 8 : 1];
    if (NROW_OK(0)) { const int r0 = NROW(0); const f32x4* xr = (const f32x4*)(xin + (size_t)r0 * DM) + lane;
#pragma unroll
        for (int j = 0; j < 8; ++j) vn[j] = xr[64 * j];
        if (COMBINE) { const uint2* y0 = (const uint2*)(Y + (size_t)(2 * r0) * DM) + lane; const uint2* y1 = (const uint2*)(Y + (size_t)(2 * r0 + 1) * DM) + lane;
#pragma unroll
            for (int j = 0; j < 8; ++j) { yn0[j] = y0[64 * j]; yn1[j] = y1[64 * j]; } } }
#pragma unroll 1
    for (int it = 0; it < npass * RPP; ++it) {
        const int ps = it / RPP, i = it % RPP; (void)ps;
        const int chunk = blockIdx.x + ps * G;
        {
            const int row = NROW(it);
            if (row < M) {
                f32x4 v[8]; float s = 0.f; uint2 ya[COMBINE ? 8 : 1], yb[COMBINE ? 8 : 1];
#pragma unroll
                for (int j = 0; j < 8; ++j) v[j] = vn[j];
                if (COMBINE) {
#pragma unroll
                    for (int j = 0; j < 8; ++j) { ya[j] = yn0[j]; yb[j] = yn1[j]; } }
                if (NROW_OK(it + 1)) { const int r1 = NROW(it + 1); const f32x4* xr = (const f32x4*)(xin + (size_t)r1 * DM) + lane;
#pragma unroll
                    for (int j = 0; j < 8; ++j) vn[j] = xr[64 * j];
                    if (COMBINE) { const uint2* y0 = (const uint2*)(Y + (size_t)(2 * r1) * DM) + lane; const uint2* y1 = (const uint2*)(Y + (size_t)(2 * r1 + 1) * DM) + lane;
#pragma unroll
                        for (int j = 0; j < 8; ++j) { yn0[j] = y0[64 * j]; yn1[j] = y1[64 * j]; } } }
                if (COMBINE) {
#pragma unroll
                    for (int j = 0; j < 8; ++j) { const uint2 a = ya[j], b = yb[j];
                        v[j].x += bflo(a.x) + bflo(b.x); v[j].y += bfhi(a.x) + bfhi(b.x); v[j].z += bflo(a.y) + bflo(b.y); v[j].w += bfhi(a.y) + bfhi(b.y); }
                    if (MODE != 3) { f32x4* xo = (f32x4*)(xout + (size_t)row * DM) + lane;
#pragma unroll
                        for (int j = 0; j < 8; ++j) xo[64 * j] = v[j]; }
                }
#pragma unroll
                for (int j = 0; j < 8; ++j) s += (v[j].x * v[j].x + v[j].y * v[j].y) + (v[j].z * v[j].z + v[j].w * v[j].w);
                const float inv = __builtin_amdgcn_rsqf(wave_sum(s) * (1.0f / DM) + RMS_EPS);
#pragma unroll
                for (int j = 0; j < 8; ++j) v[j] = (v[j] * inv) * gv[j];
                if (MODE != 3 && OUTQ == 2) { unsigned* o4 = (unsigned*)((unsigned char*)H + (size_t)row * DM) + lane;
                    float am = 0.f;
#pragma unroll
                    for (int j = 0; j < 8; ++j) am = fmaxf(am, fmaxf(fmaxf(fabsf(v[j].x), fabsf(v[j].y)), fmaxf(fabsf(v[j].z), fabsf(v[j].w))));
                    am = wave_max(am); const float qi = am > 0.f ? 127.0f / am : 0.f;
#pragma unroll
                    for (int j = 0; j < 8; ++j) o4[64 * j] = pack_i8x4(v[j].x * qi, v[j].y * qi, v[j].z * qi, v[j].w * qi);
                    if (lane == 0) { if (MODE == 4) rt_s[wave * 8 + i] = am * (1.0f / 127.0f); else sx[row] = am * (1.0f / 127.0f); } }
                else if (MODE != 3 && OUTQ == 1) { unsigned* o4 = (unsigned*)((unsigned char*)H + (size_t)row * DM) + lane;
#pragma unroll
                    for (int j = 0; j < 8; ++j) o4[64 * j] = pg8::pack_fp8x4(v[j].x, v[j].y, v[j].z, v[j].w); }
                else if (MODE != 3) { unsigned long long* o8 = (unsigned long long*)(H + (size_t)row * DM) + lane;
#pragma unroll
                    for (int j = 0; j < 8; ++j) o8[64 * j] = (unsigned long long)pk2(v[j].x, v[j].y) | ((unsigned long long)pk2(v[j].z, v[j].w) << 32); }
                else { f32x4* o = (f32x4*)(fout + (size_t)row * DM) + lane;
#pragma unroll
                    for (int j = 0; j < 8; ++j) o[64 * j] = v[j]; }
                if (MODE == 1 || MODE == 4) {
                    float a8[8];
#pragma unroll
                    for (int c = 0; c < 8; ++c) a8[c] = 0.f;
#pragma unroll
                    for (int j = 0; j < 8; ++j) {
#pragma unroll
                        for (int c = 0; c < 8; ++c) { const f32x4 w = *(const LAS f32x4*)(W8t + c * DM + 4 * (lane + 64 * j)); a8[c] += (v[j].x * w.x + v[j].y * w.y) + (v[j].z * w.z + v[j].w * w.w); } }
                    const bool b5 = (lane & 32) != 0, b4 = (lane & 16) != 0, b3 = (lane & 8) != 0;
                    float r4[4], r2[2];
#pragma unroll
                    for (int k = 0; k < 4; ++k) { const float mine = b5 ? a8[4 + k] : a8[k], send = b5 ? a8[k] : a8[4 + k]; r4[k] = mine + lx(send, 32, lane); }
#pragma unroll
                    for (int k = 0; k < 2; ++k) { const float mine = b4 ? r4[2 + k] : r4[k], send = b4 ? r4[k] : r4[2 + k]; r2[k] = mine + lx(send, 16, lane); }
                    float val; { const float mine = b3 ? r2[1] : r2[0], send = b3 ? r2[0] : r2[1]; val = mine + lx(send, 8, lane); }
                    val += lx(val, 4, lane); val += lx(val, 2, lane); val += lx(val, 1, lane);
                    if (MODE == 1) {
                        if ((lane & 7) == 0) { const int hh = lane >> 3; const float t = val + bias8[hh]; const float t2 = t * LOG2E; ex_out[(size_t)((row >> 12) * 8 + hh) * SEQ + (row & (SEQ - 1))] = -(fmaxf(-t2, 0.f) + __builtin_amdgcn_logf(1.0f + __builtin_amdgcn_exp2f(-fabsf(t2))));     }
                    } else {
                        float p[8];
#pragma unroll
                        for (int c = 0; c < 8; ++c) p[c] = __uint_as_float((unsigned)__builtin_amdgcn_readlane((int)__float_as_uint(val), 8 * c));
                        int e1 = 0; float v1 = p[0];
#pragma unroll
                        for (int c = 1; c < 8; ++c) if (p[c] > v1) { v1 = p[c]; e1 = c; }
                        int e2 = -1; float v2 = -__builtin_inff();
#pragma unroll
                        for (int c = 0; c < 8; ++c) if (c != e1 && p[c] > v2) { v2 = p[c]; e2 = c; }
                        const float t = __builtin_amdgcn_exp2f((v2 - v1) * LOG2E), g1 = 1.0f / (1.0f + t), g2 = t / (1.0f + t);
                        if (lane == 0) { const int rl = wave * 8 + i; rt_e[rl] = e1 | (e2 << 8); rt_g[2 * rl] = g1; rt_g[2 * rl + 1] = g2; }
                    }
                }
            }
        }
        if (MODE == 4 && i == RPP - 1) {
            __syncthreads();
            if (wave == 0 && chunk < M / 64) {
                const int ee = rt_e[lane], e1 = ee & 255, e2 = ee >> 8; const float g1 = rt_g[2 * lane], g2 = rt_g[2 * lane + 1];
                const unsigned long long lt = (1ull << lane) - 1ull;
                int cA[8], cB[8], tot = 0, pA = 0, pB = 0;
#pragma unroll
                for (int e = 0; e < 8; ++e) { const unsigned long long bA = __ballot(e1 == e), bB = __ballot(e2 == e); cA[e] = __popcll(bA); cB[e] = __popcll(bB);
                    if (e1 == e) pA = __popcll(bA & lt); if (e2 == e) pB = cA[e] + __popcll(bB & lt); tot = (lane == e) ? cA[e] + cB[e] : tot; }
                unsigned basev = 0; if (lane < 8) basev = __hip_atomic_fetch_add(mcnt + lane, (unsigned)tot, __ATOMIC_RELAXED, __HIP_MEMORY_SCOPE_AGENT);
                int b1 = 0, b2 = 0;
#pragma unroll
                for (int e = 0; e < 8; ++e) { const int be = __builtin_amdgcn_readlane((int)basev, e); if (e1 == e) b1 = be; if (e2 == e) b2 = be; }
                const int tok = chunk * 64 + lane;
                mlist[e1 * 16384 + b1 + pA] = tok * 2; mgate[e1 * 16384 + b1 + pA] = g1;
                mlist[e2 * 16384 + b2 + pB] = tok * 2 + 1; mgate[e2 * 16384 + b2 + pB] = g2;
                if (OUTQ == 2) { const float s = rt_s[lane]; msc[e1 * 16384 + b1 + pA] = s; msc[e2 * 16384 + b2 + pB] = s; }
            }
            __syncthreads();
        }
    }
#undef NROW
#undef NROW_OK
}

__device__ __forceinline__ void cumsum_seq(const float* logf, float* c2, int bh, int lane) {
    const f32x4* lf = (const f32x4*)(logf + (size_t)bh * SEQ + 64 * lane);
    f32x4 v[16]; float loc = 0.f;
#pragma unroll
    for (int i = 0; i < 16; ++i) { v[i] = lf[i]; loc += (v[i].x + v[i].y) + (v[i].z + v[i].w); }
    float incl = loc;
#pragma unroll
    for (int off = 1; off < 64; off <<= 1) { const float y = __uint_as_float((unsigned)__builtin_amdgcn_ds_bpermute(((lane - off) & 63) << 2, (int)__float_as_uint(incl))); if (lane >= off) incl += y; }
    float run = incl - loc;
    f32x4* co = (f32x4*)(c2 + (size_t)bh * SEQ + 64 * lane);
#pragma unroll
    for (int i = 0; i < 16; ++i) { f32x4 o; run += v[i].x; o.x = run; run += v[i].y; o.y = run; run += v[i].z; o.z = run; run += v[i].w; o.w = run; co[i] = o; }
}

__device__ __forceinline__ void unpack8(const v4u w, float (&f)[8]) { f[0] = bflo(w.x); f[1] = bfhi(w.x); f[2] = bflo(w.y); f[3] = bfhi(w.y); f[4] = bflo(w.z); f[5] = bfhi(w.z); f[6] = bflo(w.w); f[7] = bfhi(w.w); }
template <bool O8>
__device__ __forceinline__ void conv_phase(const bf16* P2, const float* cw, bf16* Y, int gt, int NGT) {
    constexpr int LDP = 4096;
    for (int item = gt; item < (M / 16) * 256; item += NGT) {
        const int cg = item & 255, ci = item >> 8, c0 = cg * 8, t0 = ci * 16;
        float w0[8], w1[8], w2[8];
#pragma unroll
        for (int i = 0; i < 8; ++i) { w0[i] = cw[c0 + i]; w1[i] = cw[DM + c0 + i]; w2[i] = cw[2 * DM + c0 + i]; }
        float gm2[8], gm1[8];
#pragma unroll
        for (int i = 0; i < 8; ++i) { gm2[i] = 0.f; gm1[i] = 0.f; }
        if ((t0 & (SEQ - 1)) != 0) { unpack8(*(const v4u*)(P2 + (size_t)(t0 - 2) * LDP + DM + c0), gm2); unpack8(*(const v4u*)(P2 + (size_t)(t0 - 1) * LDP + DM + c0), gm1); }
        v4u rb[16], rg[16];
#pragma unroll
        for (int r = 0; r < 16; ++r) { rb[r] = *(const v4u*)(P2 + (size_t)(t0 + r) * LDP + c0); rg[r] = *(const v4u*)(P2 + (size_t)(t0 + r) * LDP + DM + c0); }
        asm volatile("" ::: "memory");
#pragma unroll
        for (int r = 0; r < 16; ++r) {
            const size_t row = (size_t)(t0 + r);
            float gb[8], g[8], y[8];
            unpack8(rb[r], gb); unpack8(rg[r], g);
#pragma unroll
            for (int i = 0; i < 8; ++i) { y[i] = gb[i] * (w0[i] * gm2[i] + w1[i] * gm1[i] + w2[i] * g[i]); gm2[i] = gm1[i]; gm1[i] = g[i]; }
            if (O8) { uint2 o; o.x = pg8::pack_fp8x4(2.0f * y[0], 2.0f * y[1], 2.0f * y[2], 2.0f * y[3]); o.y = pg8::pack_fp8x4(2.0f * y[4], 2.0f * y[5], 2.0f * y[6], 2.0f * y[7]);
                *(uint2*)((unsigned char*)Y + row * DM + c0) = o; }
            else { v4u o; o.x = pk2(y[0], y[1]); o.y = pk2(y[2], y[3]); o.z = pk2(y[4], y[5]); o.w = pk2(y[6], y[7]);
            *(v4u*)(Y + row * DM + c0) = o; }
        }
    }
}

__device__ __forceinline__ int moe_table(LAS int* tab, const unsigned* mcnt, int tid) {
    if (tid < 64) {
        const int lane = tid, c = lane < NE ? (int)__hip_atomic_load(mcnt + (lane & 7), __ATOMIC_RELAXED, __HIP_MEMORY_SCOPE_AGENT) : 0, np = (c + 255) >> 8;
        int incl = np;
#pragma unroll
        for (int o = 1; o < 8; o <<= 1) { const int y = __builtin_amdgcn_ds_bpermute(((lane - o) & 63) << 2, incl); if (lane >= o) incl += y; }
        const int off = incl - np;
        if (lane < NE) { tab[lane] = c;
            for (int p = 0; p < np; ++p) { tab[8 + off + p] = lane; tab[160 + off + p] = p * 256; }
            if (lane == NE - 1) tab[300] = incl; }
    }
    __syncthreads();
    return __builtin_amdgcn_readfirstlane(tab[300]);
}

#define WSP(off) (kargs()->ws + (off))
__device__ __forceinline__ unsigned lds_off() { unsigned z = 0; asm volatile("" : "+s"(z)); return z; }
__global__ void __launch_bounds__(NWAVES * 64, 2) mega_fwd(Args args_unused) {
    extern __shared__ __attribute__((aligned(16))) unsigned char lds_raw[];
#define LDSP ((LAS unsigned char*)lds_raw + lds_off())
    volatile LAS unsigned* MISC = (volatile LAS unsigned*)((LAS unsigned char*)lds_raw + MISC_OFF);
#define TID_DECL int tid = wv * 64 + lane_id_asm(); asm volatile("" : "+v"(tid)); const int lane = tid & 63, wave = __builtin_amdgcn_readfirstlane(tid >> 6); const int G = gridDim.x, gw = blockIdx.x * NWAVES + wave, NGW = G * NWAVES; (void)lane; (void)gw; (void)NGW; (void)G
    const int wv = __builtin_amdgcn_readfirstlane((int)threadIdx.x >> 6);
#define T0() (wv == 0 && lane_id_asm() == 0)
    { TID_DECL;
    for (int u = tid; u < (LDS_BYTES - LDSCTL_OFF) / 4; u += NWAVES * 64) ((LAS unsigned*)((LAS unsigned char*)lds_raw + LDSCTL_OFF))[u] = 0u;
    __syncthreads(); }
    XcdBarrier bar; bar.bar = (unsigned*)(WSP(WS_CTL)) + CW_BAR + kargs()->li * XCD_BAR_WORDS; bar.x = 0; bar.st = nullptr;
    if (ONE_LAUNCH) bar = xcd_barrier_post((unsigned*)(WSP(WS_CTL)) + CW_BAR + kargs()->li * XCD_BAR_WORDS, MISC + 8, T0());
    const int G = gridDim.x;
#define GRID_BAR() do { if (ONE_LAUNCH) { XcdBarrier b_ = bar; b_.bar = (unsigned*)(WSP(WS_CTL)) + CW_BAR + kargs()->li * XCD_BAR_WORDS; xcd_barrier(b_, T0()); } } while (0)
    const int lo = kargs()->ph_lo, hi = kargs()->ph_hi;
#define IN(k) (lo <= (k) && (k) < hi)
#define BOTH(k) (IN(k) && IN((k) + 1))
#define GEMM_PHASE(EPI, Aptr, Bptr, N_, K_, Eobj) do { pg8::Gemm g{(const pg8::bf16_t*)(Aptr), (const pg8::bf16_t*)(Bptr), M, (N_), (K_)}; pg8::StaticOrder S; S.init(M, (N_), G, (int)blockIdx.x); \
        pg8::gemm_phase<EPI, pg8::StaticOrder, PG8_ALIGN, PG8_SP2>(lds + RING_OFF, g, S, Eobj, wv); } while (0)

    if (IN(0)) { TID_DECL; LAS unsigned char* lds = LDSP; (void)lds;
        LAS float* scr = (LAS float*)(lds + RING_OFF + wave * 16384);
        if (I8_AIN_MASK || I8_CIN_MASK || I8_GU_MASK || I8_MGU_MASK) { LAS float* smax = (LAS float*)(lds + RING_OFF + 12288);
            p0_i8_stream(scr, smax, wave, lane, G); }
        for (int it = gw; it < 2 * IT_PER_J; it += NGW) p0_item(it, scr, lane);
#if P0_NOBAR
        __syncthreads();
#else
        if (BOTH(0)) GRID_BAR();
#endif
    }
#pragma unroll
    for (int lp = 0; lp < 2; ++lp) {
        const int pb = 1 + lp * PH_PER_LP, la = 2 * lp, lc = 2 * lp + 1;
        if (IN(pb + 0)) { TID_DECL; LAS unsigned char* lds = LDSP; (void)lds;
            const kargs_t KA = kargs();
            if (lp == 0) { if (I8_AIN_LP(lp)) norm_phase<1, false, 2>(lds, wave, lane, tid, KA->in[I_X], nullptr, nullptr, KA->in[I_MIXN] + (size_t)la * DM, (bf16*)(KA->ws + WS_H), nullptr,
                          KA->in[I_WINATT] + (size_t)lp * DM * ATT_SRC_LD + 3072, ATT_SRC_LD, KA->in[I_BFORGET] + lp * 8, (float*)(KA->ws + WS_LOGF), nullptr, nullptr, nullptr, (float*)(KA->ws + WS_SX)); else norm_phase<1, false, 0>(lds, wave, lane, tid, KA->in[I_X], nullptr, nullptr, KA->in[I_MIXN] + (size_t)la * DM, (bf16*)(KA->ws + WS_H), nullptr,
                          KA->in[I_WINATT] + (size_t)lp * DM * ATT_SRC_LD + 3072, ATT_SRC_LD, KA->in[I_BFORGET] + lp * 8, (float*)(KA->ws + WS_LOGF), nullptr, nullptr, nullptr, (float*)(KA->ws + WS_SX)); }
            else { if (I8_AIN_LP(lp)) norm_phase<1, true, 2>(lds, wave, lane, tid, KA->out, KA->out, (const bf16*)(KA->ws + WS_Y), KA->in[I_MIXN] + (size_t)la * DM, (bf16*)(KA->ws + WS_H), nullptr,
                          KA->in[I_WINATT] + (size_t)lp * DM * ATT_SRC_LD + 3072, ATT_SRC_LD, KA->in[I_BFORGET] + lp * 8, (float*)(KA->ws + WS_LOGF), nullptr, nullptr, nullptr, (float*)(KA->ws + WS_SX)); else norm_phase<1, true, 0>(lds, wave, lane, tid, KA->out, KA->out, (const bf16*)(KA->ws + WS_Y), KA->in[I_MIXN] + (size_t)la * DM, (bf16*)(KA->ws + WS_H), nullptr,
                          KA->in[I_WINATT] + (size_t)lp * DM * ATT_SRC_LD + 3072, ATT_SRC_LD, KA->in[I_BFORGET] + lp * 8, (float*)(KA->ws + WS_LOGF), nullptr, nullptr, nullptr, (float*)(KA->ws + WS_SX)); }
            if (BOTH(pb + 0)) GRID_BAR();
        }
        if (IN(pb + 1)) { LAS unsigned char* lds = LDSP; (void)lds;
            { TID_DECL; if (blockIdx.x < 32 && wave == 0) cumsum_seq((const float*)WSP(WS_LOGF), (float*)WSP(WS_C2), blockIdx.x, lane); }
            if (I8_AIN_LP(lp)) { pg8::EpiQKVT<true> E{(pg8::bf16_t*)WSP(WS_QKV), NATT, (unsigned*)WSP(WS_CTL) + CW_KMAX + lp * 128, (const float*)WSP(WS_SX), (const float*)WSP(WS_WSC) + WSC_AIN + lp * 6144};
                pg8::Gemm g{(const pg8::bf16_t*)WSP(WS_H), (const pg8::bf16_t*)WSP(WS_AIN + lp * SZ_AIN), M, NATT, DM / 2}; pg8::StaticOrder S; S.init(M, NATT, G, (int)blockIdx.x);
                pg8::gemm_phase<pg8::EpiQKVT<true>, pg8::StaticOrder, PG8_ALIGN, PG8_SP2, 2>(lds + RING_OFF, g, S, E, wv); }
            else { pg8::EpiQKV E{(pg8::bf16_t*)WSP(WS_QKV), NATT, (unsigned*)WSP(WS_CTL) + CW_KMAX + lp * 128};
                GEMM_PHASE(pg8::EpiQKV, WSP(WS_H), WSP(WS_AIN + lp * SZ_AIN), NATT, DM, E); }
            if (BOTH(pb + 1)) GRID_BAR();
        }
        if (IN(pb + 2)) { LAS unsigned char* lds = LDSP; (void)lds;
            if (AOUT8_LP(lp)) {
#if ATT_DYN_SB == 3
            att::attn_queue<FOX_EARLY_EXIT, SB_EARLY_EXIT, true>((char*)lds_raw + lds_off(), (const att::bf16*)WSP(WS_QKV), (const att::bf16*)WSP(WS_C2), (att::bf16*)WSP(WS_O), (const unsigned*)WSP(WS_CTL) + CW_KMAX + lp * 128,
                                                                       (unsigned*)WSP(WS_CTL) + CW_ATTQ + lp, (volatile unsigned*)(MISC + 16), wv, T0());
#else
#if ATT_DYN_SB != 2
            for (int L = blockIdx.x; L < 256; L += G) att::attn_stream<0, FOX_EARLY_EXIT, true>((char*)lds_raw + lds_off(), (const att::bf16*)WSP(WS_QKV), (const att::bf16*)WSP(WS_C2), (att::bf16*)WSP(WS_O), L, (const unsigned*)WSP(WS_CTL) + CW_KMAX + lp * 128, wv);
#endif
#if ATT_DYN_SB
            for (;;) {
                __syncthreads();
                if (T0()) MISC[16] = __hip_atomic_fetch_add((unsigned*)WSP(WS_CTL) + CW_ATTQ + lp, 1u, __ATOMIC_RELAXED, __HIP_MEMORY_SCOPE_AGENT);
                __syncthreads();
                const int it = __builtin_amdgcn_readfirstlane((int)MISC[16]);
#if ATT_DYN_SB == 2
                if (it >= 1024) break;
                if (it < 512) { att::attn_one<0, FOX_EARLY_EXIT, true>((char*)lds_raw + lds_off(), (const att::bf16*)WSP(WS_QKV), (const att::bf16*)WSP(WS_C2), (att::bf16*)WSP(WS_O), it & 31, 15 - (it >> 5), (const unsigned*)WSP(WS_CTL) + CW_KMAX + lp * 128, wv); continue; }
#else
                if (it >= 512) break;
#endif
                att::attn_one<1, SB_EARLY_EXIT, true>((char*)lds_raw + lds_off(), (const att::bf16*)WSP(WS_QKV), (const att::bf16*)WSP(WS_C2), (att::bf16*)WSP(WS_O), it & 31, 15 - ((it & 511) >> 5), nullptr, wv);
            }
#else
            for (int L = blockIdx.x; L < 256; L += G) att::attn_stream<1, SB_EARLY_EXIT, true>((char*)lds_raw + lds_off(), (const att::bf16*)WSP(WS_QKV), (const att::bf16*)WSP(WS_C2), (att::bf16*)WSP(WS_O), L, nullptr, wv);
#endif
#endif
            } else {
#if ATT_DYN_SB == 3
            att::attn_queue<FOX_EARLY_EXIT, SB_EARLY_EXIT, false>((char*)lds_raw + lds_off(), (const att::bf16*)WSP(WS_QKV), (const att::bf16*)WSP(WS_C2), (att::bf16*)WSP(WS_O), (const unsigned*)WSP(WS_CTL) + CW_KMAX + lp * 128,
                                                                       (unsigned*)WSP(WS_CTL) + CW_ATTQ + lp, (volatile unsigned*)(MISC + 16), wv, T0());
#else
#if ATT_DYN_SB != 2
            for (int L = blockIdx.x; L < 256; L += G) att::attn_stream<0, FOX_EARLY_EXIT, false>((char*)lds_raw + lds_off(), (const att::bf16*)WSP(WS_QKV), (const att::bf16*)WSP(WS_C2), (att::bf16*)WSP(WS_O), L, (const unsigned*)WSP(WS_CTL) + CW_KMAX + lp * 128, wv);
#endif
#if ATT_DYN_SB
#ifdef PROBE_ATT2
            for (int rep_ = 0; rep_ < PROBE_ATT2; ++rep_)
#else
            constexpr int rep_ = 0;
#endif
            for (;;) {
                __syncthreads();
                if (T0()) MISC[16] = __hip_atomic_fetch_add((unsigned*)WSP(WS_CTL) + CW_ATTQ + lp + 2 * rep_, 1u, __ATOMIC_RELAXED, __HIP_MEMORY_SCOPE_AGENT);
                __syncthreads();
                const int it = __builtin_amdgcn_readfirstlane((int)MISC[16]);
#if ATT_DYN_SB == 2
                if (it >= 1024) break;
                if (it < 512) { att::attn_one<0, FOX_EARLY_EXIT, false>((char*)lds_raw + lds_off(), (const att::bf16*)WSP(WS_QKV), (const att::bf16*)WSP(WS_C2), (att::bf16*)WSP(WS_O), it & 31, 15 - (it >> 5), (const unsigned*)WSP(WS_CTL) + CW_KMAX + lp * 128, wv); continue; }
#else
                if (it >= 512) break;
#endif
                att::attn_one<1, SB_EARLY_EXIT, false>((char*)lds_raw + lds_off(), (const att::bf16*)WSP(WS_QKV), (const att::bf16*)WSP(WS_C2), (att::bf16*)WSP(WS_O), it & 31, 15 - ((it & 511) >> 5), nullptr, wv);
            }
#else
            for (int L = blockIdx.x; L < 256; L += G) att::attn_stream<1, SB_EARLY_EXIT, false>((char*)lds_raw + lds_off(), (const att::bf16*)WSP(WS_QKV), (const att::bf16*)WSP(WS_C2), (att::bf16*)WSP(WS_O), L, nullptr, wv);
#endif
#endif
            }
            if (BOTH(pb + 2)) GRID_BAR();
        }
        if (IN(pb + 3)) { LAS unsigned char* lds = LDSP; (void)lds;
            const kargs_t KA = kargs();
            pg8::EpiRes E{lp == 0 ? KA->in[I_X] : KA->out, KA->out, DM, nullptr, 0};
            if (AOUT8_LP(lp)) { pg8::Gemm g{(const pg8::bf16_t*)WSP(WS_O), (const pg8::bf16_t*)WSP(WS_AOUT + lp * SZ_SQ), M, DM, DM / 2, 0x7B7B7B7B}; pg8::StaticOrder S; S.init(M, DM, G, (int)blockIdx.x);
                pg8::gemm_phase<pg8::EpiRes, pg8::StaticOrder, PG8_ALIGN, PG8_SP2, 1>(lds + RING_OFF, g, S, E, wv); }
            else GEMM_PHASE(pg8::EpiRes, WSP(WS_O), WSP(WS_AOUT + lp * SZ_SQ), DM, DM, E);
            if (BOTH(pb + 3)) GRID_BAR();
        }
        if (IN(pb + 4)) { TID_DECL; LAS unsigned char* lds = LDSP; (void)lds;
            const kargs_t KA = kargs();
            if (I8_GU_LP(lp)) norm_phase<0, false, 2>(lds, wave, lane, tid, KA->out, nullptr, nullptr, KA->in[I_FFNN] + (size_t)la * DM, (bf16*)(KA->ws + WS_H), nullptr, nullptr, 0, nullptr, nullptr, nullptr, nullptr, nullptr, (float*)(KA->ws + WS_SX));
            else if (FFN_GU8_LP(lp)) norm_phase<0, false, 1>(lds, wave, lane, tid, KA->out, nullptr, nullptr, KA->in[I_FFNN] + (size_t)la * DM, (bf16*)(KA->ws + WS_H), nullptr, nullptr, 0, nullptr, nullptr, nullptr, nullptr, nullptr);
            else norm_phase<0, false, 0>(lds, wave, lane, tid, KA->out, nullptr, nullptr, KA->in[I_FFNN] + (size_t)la * DM, (bf16*)(KA->ws + WS_H), nullptr, nullptr, 0, nullptr, nullptr, nullptr, nullptr, nullptr);
            if (BOTH(pb + 4)) GRID_BAR();
        }
        if (IN(pb + 5)) { LAS unsigned char* lds = LDSP; (void)lds;
            if (I8_GU_LP(lp)) { pg8::Gemm g{(const pg8::bf16_t*)WSP(WS_H), (const pg8::bf16_t*)WSP(WS_GU + lp * SZ_GU), M, 2 * FF, DM / 2}; pg8::StaticOrder S; S.init(M, 2 * FF, G, (int)blockIdx.x);
                if (FFN_DN8_LP(lp)) { pg8::EpiSwiGLU8T<1> E{(unsigned char*)WSP(WS_ACT), FF, (const float*)WSP(WS_SX), (const float*)WSP(WS_WSC) + WSC_GU + lp * 11264, nullptr}; pg8::gemm_phase<pg8::EpiSwiGLU8T<1>, pg8::StaticOrder, PG8_ALIGN, PG8_SP2, 2>(lds + RING_OFF, g, S, E, wv); }
                else { pg8::EpiSwiGLUT<1> E{(pg8::bf16_t*)WSP(WS_ACT), FF, (const float*)WSP(WS_SX), (const float*)WSP(WS_WSC) + WSC_GU + lp * 11264, nullptr}; pg8::gemm_phase<pg8::EpiSwiGLUT<1>, pg8::StaticOrder, PG8_ALIGN, PG8_SP2, 2>(lds + RING_OFF, g, S, E, wv); } }
            else if (FFN_GU8_LP(lp)) { pg8::Gemm g{(const pg8::bf16_t*)WSP(WS_H), (const pg8::bf16_t*)WSP(WS_GU + lp * SZ_GU), M, 2 * FF, DM / 2}; pg8::StaticOrder S; S.init(M, 2 * FF, G, (int)blockIdx.x);
                if (FFN_DN8_LP(lp)) { pg8::EpiSwiGLU8 E{(unsigned char*)WSP(WS_ACT), FF}; pg8::gemm_phase<pg8::EpiSwiGLU8, pg8::StaticOrder, PG8_ALIGN, PG8_SP2, 1>(lds + RING_OFF, g, S, E, wv); }
                else { pg8::EpiSwiGLU E{(pg8::bf16_t*)WSP(WS_ACT), FF}; pg8::gemm_phase<pg8::EpiSwiGLU, pg8::StaticOrder, PG8_ALIGN, PG8_SP2, 1>(lds + RING_OFF, g, S, E, wv); } }
            else { if (FFN_DN8_LP(lp)) { pg8::EpiSwiGLU8 E{(unsigned char*)WSP(WS_ACT), FF}; GEMM_PHASE(pg8::EpiSwiGLU8, WSP(WS_H), WSP(WS_GU + lp * SZ_GU), 2 * FF, DM, E); }
                else { pg8::EpiSwiGLU E{(pg8::bf16_t*)WSP(WS_ACT), FF}; GEMM_PHASE(pg8::EpiSwiGLU, WSP(WS_H), WSP(WS_GU + lp * SZ_GU), 2 * FF, DM, E); } }
            if (BOTH(pb + 5)) GRID_BAR();
        }
        if (IN(pb + 6)) { LAS unsigned char* lds = LDSP; (void)lds;
            const kargs_t KA = kargs();
            pg8::EpiRes E{KA->out, KA->out, DM, nullptr, 0};
            if (FFN_DN8_LP(lp)) { pg8::Gemm g{(const pg8::bf16_t*)WSP(WS_ACT), (const pg8::bf16_t*)WSP(WS_DN + lp * SZ_DN), M, DM, FF / 2}; pg8::StaticOrder S; S.init(M, DM, G, (int)blockIdx.x);
                pg8::gemm_phase<pg8::EpiRes, pg8::StaticOrder, PG8_ALIGN, PG8_SP2, 1>(lds + RING_OFF, g, S, E, wv); }
            else GEMM_PHASE(pg8::EpiRes, WSP(WS_ACT), WSP(WS_DN + lp * SZ_DN), DM, FF, E);
            if (BOTH(pb + 6)) GRID_BAR();
        }
        if (IN(pb + 7)) { TID_DECL; LAS unsigned char* lds = LDSP; (void)lds;
            const kargs_t KA = kargs();
            if (I8_CIN_LP(lp)) norm_phase<0, false, 2>(lds, wave, lane, tid, KA->out, nullptr, nullptr, KA->in[I_MIXN] + (size_t)lc * DM, (bf16*)(KA->ws + WS_H), nullptr, nullptr, 0, nullptr, nullptr, nullptr, nullptr, nullptr, (float*)(KA->ws + WS_SX)); else norm_phase<0, false, 0>(lds, wave, lane, tid, KA->out, nullptr, nullptr, KA->in[I_MIXN] + (size_t)lc * DM, (bf16*)(KA->ws + WS_H), nullptr, nullptr, 0, nullptr, nullptr, nullptr, nullptr, nullptr, (float*)(KA->ws + WS_SX));
            if (BOTH(pb + 7)) GRID_BAR();
        }
        if (IN(pb + 8)) { LAS unsigned char* lds = LDSP; (void)lds;
            if (I8_CIN_LP(lp)) { pg8::EpiConvInT<true> E{(pg8::bf16_t*)WSP(WS_QKV), (const float*)WSP(WS_SX), (const float*)WSP(WS_WSC) + WSC_CIN + lp * 6144};
                pg8::Gemm g{(const pg8::bf16_t*)WSP(WS_H), (const pg8::bf16_t*)WSP(WS_CIN + lp * SZ_AIN), M, NATT, DM / 2}; pg8::StaticOrder S; S.init(M, NATT, G, (int)blockIdx.x);
                pg8::gemm_phase<pg8::EpiConvInT<true>, pg8::StaticOrder, PG8_ALIGN, PG8_SP2, 2>(lds + RING_OFF, g, S, E, wv); }
            else { pg8::EpiConvInT<false> E{(pg8::bf16_t*)WSP(WS_QKV), nullptr, nullptr};
                GEMM_PHASE(pg8::EpiConvInT<false>, WSP(WS_H), WSP(WS_CIN + lp * SZ_AIN), NATT, DM, E); }
            if (BOTH(pb + 8)) GRID_BAR();
        }
        if (IN(pb + 9)) { TID_DECL; LAS unsigned char* lds = LDSP; (void)lds;
            const kargs_t KA = kargs();
            if (COUT8_LP(lp)) conv_phase<true>((const bf16*)(KA->ws + WS_QKV), KA->in[I_CONVW] + (size_t)lp * 3 * DM, (bf16*)(KA->ws + WS_O), blockIdx.x * NWAVES * 64 + tid, G * NWAVES * 64);
            else conv_phase<false>((const bf16*)(KA->ws + WS_QKV), KA->in[I_CONVW] + (size_t)lp * 3 * DM, (bf16*)(KA->ws + WS_O), blockIdx.x * NWAVES * 64 + tid, G * NWAVES * 64);
            if (BOTH(pb + 9)) GRID_BAR();
        }
        if (IN(pb + 10)) { LAS unsigned char* lds = LDSP; (void)lds;
            const kargs_t KA = kargs();
            pg8::EpiRes E{KA->out, KA->out, DM, nullptr, 0};
            if (COUT8_LP(lp)) { pg8::Gemm g{(const pg8::bf16_t*)WSP(WS_O), (const pg8::bf16_t*)WSP(WS_COUT + lp * SZ_SQ), M, DM, DM / 2, 0x7E7E7E7E}; pg8::StaticOrder S; S.init(M, DM, G, (int)blockIdx.x);
                pg8::gemm_phase<pg8::EpiRes, pg8::StaticOrder, PG8_ALIGN, PG8_SP2, 1>(lds + RING_OFF, g, S, E, wv); }
            else GEMM_PHASE(pg8::EpiRes, WSP(WS_O), WSP(WS_COUT + lp * SZ_SQ), DM, DM, E);
            if (BOTH(pb + 10)) GRID_BAR();
        }
        if (IN(pb + 11)) { TID_DECL; LAS unsigned char* lds = LDSP; (void)lds;
            const kargs_t KA = kargs();
            if (I8_MGU_LP(lp)) norm_phase<4, false, 2>(lds, wave, lane, tid, KA->out, nullptr, nullptr, KA->in[I_FFNN] + (size_t)lc * DM, (bf16*)(KA->ws + WS_H), nullptr, KA->in[I_WROUTER] + (size_t)lp * DM * NE, NE, nullptr, nullptr,
                                 (unsigned*)(KA->ws + WS_CTL) + CW_MOECNT + lp * 64, (int*)(KA->ws + WS_MLIST), (float*)(KA->ws + WS_MGATE), (float*)(KA->ws + WS_SX), (float*)(KA->ws + WS_MSC));
            else if (MOE_FP8_LP(lp)) norm_phase<4, false, 1>(lds, wave, lane, tid, KA->out, nullptr, nullptr, KA->in[I_FFNN] + (size_t)lc * DM, (bf16*)(KA->ws + WS_H), nullptr, KA->in[I_WROUTER] + (size_t)lp * DM * NE, NE, nullptr, nullptr,
                                 (unsigned*)(KA->ws + WS_CTL) + CW_MOECNT + lp * 64, (int*)(KA->ws + WS_MLIST), (float*)(KA->ws + WS_MGATE));
            else norm_phase<4, false, 0>(lds, wave, lane, tid, KA->out, nullptr, nullptr, KA->in[I_FFNN] + (size_t)lc * DM, (bf16*)(KA->ws + WS_H), nullptr, KA->in[I_WROUTER] + (size_t)lp * DM * NE, NE, nullptr, nullptr,
                                 (unsigned*)(KA->ws + WS_CTL) + CW_MOECNT + lp * 64, (int*)(KA->ws + WS_MLIST), (float*)(KA->ws + WS_MGATE));
            if (BOTH(pb + 11)) GRID_BAR();
        }
        if (IN(pb + 12)) { LAS unsigned char* lds = LDSP; (void)lds;
            LAS int* tab = (LAS int*)(lds + MOETAB_OFF);
            int P; { TID_DECL; P = moe_table(tab, (const unsigned*)WSP(WS_CTL) + CW_MOECNT + lp * 64, tid); }
            if (I8_MGU_LP(lp)) {
                pg8::Gemm g{(const pg8::bf16_t*)WSP(WS_H), (const pg8::bf16_t*)WSP(WS_MGU + (size_t)(lp * NE) * SZ_MGU), P * 256, 2 * FFE, DM / 2};
                pg8::MoeOrder<true> S; S.init(P, 2 * FFE, G, (int)blockIdx.x, SZ_MGU, (const int*)WSP(WS_MLIST), tab);
                if (MOE_FP8_LP(lp)) { pg8::EpiSwiGLU8T<2> E{(unsigned char*)WSP(WS_ACT), FFE, (const float*)WSP(WS_MSC), (const float*)WSP(WS_WSC) + WSC_MGU + lp * NE * 5632, tab};
                    pg8::gemm_phase<pg8::EpiSwiGLU8T<2>, pg8::MoeOrder<true>, PG8_ALIGN, PG8_SP2, 2>(lds + RING_OFF, g, S, E, wv); }
                else { pg8::EpiSwiGLUT<2> E{(pg8::bf16_t*)WSP(WS_ACT), FFE, (const float*)WSP(WS_MSC), (const float*)WSP(WS_WSC) + WSC_MGU + lp * NE * 5632, tab};
                    pg8::gemm_phase<pg8::EpiSwiGLUT<2>, pg8::MoeOrder<true>, PG8_ALIGN, PG8_SP2, 2>(lds + RING_OFF, g, S, E, wv); }
            } else if (MOE_FP8_LP(lp)) {
                pg8::Gemm g{(const pg8::bf16_t*)WSP(WS_H), (const pg8::bf16_t*)WSP(WS_MGU + (size_t)(lp * NE) * SZ_MGU), P * 256, 2 * FFE, DM / 2};
                pg8::MoeOrder<true> S; S.init(P, 2 * FFE, G, (int)blockIdx.x, SZ_MGU, (const int*)WSP(WS_MLIST), tab);
                pg8::EpiSwiGLU8 E{(unsigned char*)WSP(WS_ACT), FFE};
                pg8::gemm_phase<pg8::EpiSwiGLU8, pg8::MoeOrder<true>, PG8_ALIGN, PG8_SP2, 1>(lds + RING_OFF, g, S, E, wv);
            } else {
                pg8::Gemm g{(const pg8::bf16_t*)WSP(WS_H), (const pg8::bf16_t*)WSP(WS_MGU + (size_t)(lp * NE) * SZ_MGU), P * 256, 2 * FFE, DM};
                pg8::MoeOrder<true> S; S.init(P, 2 * FFE, G, (int)blockIdx.x, SZ_MGU, (const int*)WSP(WS_MLIST), tab);
                pg8::EpiSwiGLU E{(pg8::bf16_t*)WSP(WS_ACT), FFE};
                pg8::gemm_phase<pg8::EpiSwiGLU, pg8::MoeOrder<true>, PG8_ALIGN, PG8_SP2>(lds + RING_OFF, g, S, E, wv);
            }
            if (BOTH(pb + 12)) GRID_BAR();
        }
        if (IN(pb + 13)) { LAS unsigned char* lds = LDSP; (void)lds;
            LAS int* tab = (LAS int*)(lds + MOETAB_OFF);
            int P; { TID_DECL; P = moe_table(tab, (const unsigned*)WSP(WS_CTL) + CW_MOECNT + lp * 64, tid); }
            pg8::MoeOrder<false> S; S.init(P, DM, G, (int)blockIdx.x, SZ_MDN, (const int*)WSP(WS_MLIST), tab);
            pg8::EpiMoeDown E{(pg8::bf16_t*)WSP(WS_Y), DM, (const int*)WSP(WS_MLIST), (const float*)WSP(WS_MGATE), tab};
            if (MOE_FP8_LP(lp)) { pg8::Gemm g{(const pg8::bf16_t*)WSP(WS_ACT), (const pg8::bf16_t*)WSP(WS_MDN + (size_t)(lp * NE) * SZ_MDN), P * 256, DM, FFE / 2};
                pg8::gemm_phase<pg8::EpiMoeDown, pg8::MoeOrder<false>, PG8_ALIGN, PG8_SP2, 1>(lds + RING_OFF, g, S, E, wv); }
            else { pg8::Gemm g{(const pg8::bf16_t*)WSP(WS_ACT), (const pg8::bf16_t*)WSP(WS_MDN + (size_t)(lp * NE) * SZ_MDN), P * 256, DM, FFE};
                pg8::gemm_phase<pg8::EpiMoeDown, pg8::MoeOrder<false>, PG8_ALIGN, PG8_SP2>(lds + RING_OFF, g, S, E, wv); }
            if (BOTH(pb + 13)) GRID_BAR();
        }
    }
    if (IN(NPHASES - 1)) { TID_DECL; LAS unsigned char* lds = LDSP; (void)lds;
        const kargs_t KA = kargs();
        norm_phase<3, true>(lds, wave, lane, tid, KA->out, nullptr, (const bf16*)(KA->ws + WS_Y), KA->in[I_FINN], nullptr, KA->out, nullptr, 0, nullptr, nullptr, nullptr, nullptr, nullptr);
    }
#undef IN
#undef BOTH
}

extern "C" void kernel_launch(void* const* d_in, const int* in_sizes, int n_in, void* d_out, int out_size, void* d_ws, size_t ws_size, hipStream_t stream) {
    static int grid = 0;
    if (grid == 0) {
        if (n_in != 17 || in_sizes[0] != M * DM || out_size != M * DM || ws_size < WS_END) { fprintf(stderr, "kernel_launch: shape/workspace mismatch: n_in %d in0 %d out %d ws %zu (need %zu)\n", n_in, n_in > 0 ? in_sizes[0] : -1, out_size, ws_size, (size_t)WS_END); grid = -1; return; }
        int dev = 0, cus = 0, per_cu = 0;
        if (hipGetDevice(&dev) != hipSuccess || hipDeviceGetAttribute(&cus, hipDeviceAttributeMultiprocessorCount, dev) != hipSuccess) { grid = -1; return; }
        if (hipFuncSetAttribute((const void*)mega_fwd, hipFuncAttributeMaxDynamicSharedMemorySize, LDS_BYTES) != hipSuccess) { fprintf(stderr, "kernel_launch: hipFuncSetAttribute failed\n"); grid = -1; return; }
        if (hipOccupancyMaxActiveBlocksPerMultiprocessor(&per_cu, (const void*)mega_fwd, NWAVES * 64, LDS_BYTES) != hipSuccess || per_cu < 1)
            fprintf(stderr, "kernel_launch: note: occupancy query reports %d workgroups per CU\n", per_cu);
        (void)hipGetLastError();
        grid = cus;
    }
    if (grid < 0) return;
    if (hipMemsetAsync((char*)d_ws + WS_CTL, 0, CTL_ZERO_BYTES, stream) != hipSuccess) { fprintf(stderr, "kernel_launch: memset failed\n"); return; }
    Args a{};
    for (int i = 0; i < 17; ++i) a.in[i] = (const float*)d_in[i];
    a.out = (float*)d_out; a.ws = (unsigned char*)d_ws;
    if (ONE_LAUNCH) {
#ifdef PROBE_DUPS
        const int dups[] = {PROBE_DUPS}; int start = 0, li = 0;
        for (int d : dups) { a.ph_lo = start; a.ph_hi = d + 1; a.li = li++; hipLaunchKernelGGL(mega_fwd, dim3(grid), dim3(NWAVES * 64), LDS_BYTES, stream, a); start = d; }
        a.ph_lo = start; a.ph_hi = NPHASES; a.li = li;
        hipLaunchKernelGGL(mega_fwd, dim3(grid), dim3(NWAVES * 64), LDS_BYTES, stream, a);
#else
        a.ph_lo = 0; a.ph_hi = NPHASES; a.li = 0;
        hipLaunchKernelGGL(mega_fwd, dim3(grid), dim3(NWAVES * 64), LDS_BYTES, stream, a);
#endif
    } else {
        for (int li = 0; li < NPHASES; ++li) { a.ph_lo = li; a.ph_hi = li + 1; a.li = li; hipLaunchKernelGGL(mega_fwd, dim3(grid), dim3(NWAVES * 64), LDS_BYTES, stream, a); }
    }
    const hipError_t le = hipPeekAtLastError();
    if (le != hipSuccess) fprintf(stderr, "kernel_launch: launch failed: %s\n", hipGetErrorName(le));
}
```
